# Optimizing an MI355X kernel written in HIP

```python
import jax, jax.numpy as jnp
from jax import lax
import numpy as np

D_MODEL = 1024
BATCH = 8
SEQ = 4096
DEPTH = 4

NSA_HEADS = 8
NSA_KV_GROUPS = 2
NSA_HEAD_DIM = 64
NSA_BRANCHES = 3
CMP_BLOCK = 32
CMP_STRIDE = 16
CMP_HIDDEN = 256
SEL_BLOCK = 64
N_SELECT = 16
N_LOCAL = 2
WINDOW = 512
NSA_Q_CHUNK = 64

MLA_HEADS = 8
MLA_NOPE_DIM = 64
MLA_ROPE_DIM = 32
MLA_V_DIM = 64
Q_LORA_RANK = 256
KV_LORA_RANK = 128
ATTN_BLOCK = 128

D_FF = 4 * D_MODEL
ROPE_THETA = 10000.0
NORM_EPS = 1e-6
NEG_INF = -1e30
FORCE_BONUS = 1e4

NSA_WIDTH = NSA_HEADS * NSA_HEAD_DIM
NSA_KV_WIDTH = NSA_KV_GROUPS * NSA_HEAD_DIM
MLA_WIDTH = MLA_HEADS * MLA_V_DIM
MIX_WIDTH = NSA_WIDTH + MLA_WIDTH
IN_SIZES = (NSA_WIDTH, NSA_KV_WIDTH, NSA_KV_WIDTH, NSA_KV_WIDTH, NSA_KV_WIDTH,
            NSA_KV_WIDTH, NSA_KV_WIDTH, NSA_BRANCHES * NSA_HEADS,
            Q_LORA_RANK, KV_LORA_RANK, MLA_ROPE_DIM)
IN_WIDTH = sum(IN_SIZES)

kernel_name = "hymba_nsa_mla_hybrid_trunk"


def _rms_norm(x, gain):
    xf = x.astype(jnp.float32)
    y = xf * lax.rsqrt(jnp.mean(xf * xf, axis=-1, keepdims=True) + NORM_EPS)
    return (y * gain.astype(jnp.float32)).astype(x.dtype)


def _rope_tables(seq, dim, dtype):
    inv_freq = 1.0 / (ROPE_THETA ** (jnp.arange(0, dim, 2, dtype=jnp.float32) / dim))
    ang = jnp.arange(seq, dtype=jnp.float32)[:, None] * inv_freq[None, :]
    ang = jnp.concatenate([ang, ang], axis=-1)
    return jnp.cos(ang).astype(dtype), jnp.sin(ang).astype(dtype)


def _rope(x, cos, sin):
    half = x.shape[-1] // 2
    rot = jnp.concatenate([-x[..., half:], x[..., :half]], axis=-1)
    return x * cos[:, None, :] + rot * sin[:, None, :]


def _masked_softmax(s, mask):
    s = jnp.where(mask, s, NEG_INF)
    m = jnp.max(s, axis=-1, keepdims=True)
    e = jnp.where(mask, jnp.exp(s - m), 0.0)
    return e / jnp.maximum(jnp.sum(e, axis=-1, keepdims=True), 1e-30)


def _heads(t, n):
    b, s, w = t.shape
    return t.reshape(b, s, n, w // n)


def _compress(kv, pos_emb, w1, w2):
    B, S, G, dk = kv.shape
    ratio = CMP_BLOCK // CMP_STRIDE
    n_cmp = S // CMP_STRIDE - ratio + 1
    chunks = kv.reshape(B, S // CMP_STRIDE, CMP_STRIDE, G, dk)
    blocks = jnp.concatenate([chunks[:, i:i + n_cmp] for i in range(ratio)], axis=2)
    blocks = blocks + pos_emb[None, None, :, None, :]
    flat = jnp.swapaxes(blocks, 2, 3).reshape(B, n_cmp, G, CMP_BLOCK * dk)
    return jax.nn.silu(flat @ w1) @ w2


def _nsa(q, k_cmp, v_cmp, k_sel, v_sel, k_win, v_win, gates):
    B, S, H, dk = q.shape
    G = k_sel.shape[2]
    R = H // G
    n_cmp = k_cmp.shape[1]
    n_blk = S // SEL_BLOCK
    n_sel = min(N_SELECT, n_blk)
    QC = NSA_Q_CHUNK
    scale = dk ** -0.5
    qg = q.reshape(B, S, G, R, dk)
    gg = gates.reshape(B, S, G, R, NSA_BRANCHES)
    k_blocks = k_sel.reshape(B, n_blk, SEL_BLOCK, G, dk).transpose(0, 3, 1, 2, 4)
    v_blocks = v_sel.reshape(B, n_blk, SEL_BLOCK, G, dk).transpose(0, 3, 1, 2, 4)
    pad = ((0, 0), (WINDOW, 0), (0, 0), (0, 0))
    k_win_pad = jnp.pad(k_win, pad)
    v_win_pad = jnp.pad(v_win, pad)
    cmp_end = jnp.arange(n_cmp) * CMP_STRIDE + CMP_BLOCK - 1
    blk_ids = jnp.arange(n_blk)
    a = SEL_BLOCK // CMP_STRIDE
    b = CMP_BLOCK // CMP_STRIDE
    overlap = np.convolve(np.ones(a), np.ones(b))
    bi = jnp.arange(B)[:, None, None, None]
    gi = jnp.arange(G)[None, :, None, None]

    def chunk(c):
        s0 = c * QC
        t = s0 + jnp.arange(QC)
        qc = lax.dynamic_slice_in_dim(qg, s0, QC, axis=1)
        gc = lax.dynamic_slice_in_dim(gg, s0, QC, axis=1)
        s_cmp = jnp.einsum('bqgrd,bngd->bgrqn', qc, k_cmp, preferred_element_type=jnp.float32) * scale
        p_cmp = _masked_softmax(s_cmp, cmp_end[None, :] <= t[:, None])
        o_cmp = jnp.einsum('bgrqn,bngd->bqgrd', p_cmp.astype(v_cmp.dtype), v_cmp)
        imp = jnp.pad(p_cmp.sum(axis=2), ((0, 0), (0, 0), (0, 0), (b - 1, b - 1)))
        imp_blk = sum(float(overlap[j]) * imp[..., j:j + a * (n_blk - 1) + 1:a] for j in range(a + b - 1))
        cur = t // SEL_BLOCK
        valid = blk_ids[None, :] <= cur[:, None]
        forced = valid & ((blk_ids[None, :] == 0) | (blk_ids[None, :] > cur[:, None] - N_LOCAL))
        score = jnp.where(forced, FORCE_BONUS, jnp.where(valid, imp_blk, -1.0))
        _, idx = lax.top_k(score, n_sel)
        k_g = k_blocks[bi, gi, idx]
        v_g = v_blocks[bi, gi, idx]
        key_pos = idx[..., None] * SEL_BLOCK + jnp.arange(SEL_BLOCK)
        m_sel = (key_pos <= t[:, None, None]).reshape(B, G, 1, QC, n_sel * SEL_BLOCK)
        s_sel = jnp.einsum('bqgrd,bgqnkd->bgrqnk', qc, k_g, preferred_element_type=jnp.float32) * scale
        p_sel = _masked_softmax(s_sel.reshape(B, G, R, QC, n_sel * SEL_BLOCK), m_sel)
        o_sel = jnp.einsum('bgrqj,bgqjd->bqgrd', p_sel.astype(v_g.dtype),
                           v_g.reshape(B, G, QC, n_sel * SEL_BLOCK, dk))
        kw = lax.dynamic_slice_in_dim(k_win_pad, s0, WINDOW + QC, axis=1)
        vw = lax.dynamic_slice_in_dim(v_win_pad, s0, WINDOW + QC, axis=1)
        win_pos = s0 - WINDOW + jnp.arange(WINDOW + QC)
        m_win = ((win_pos[None, :] <= t[:, None]) & (win_pos[None, :] > t[:, None] - WINDOW)
                 & (win_pos[None, :] >= 0))
        s_win = jnp.einsum('bqgrd,bkgd->bgrqk', qc, kw, preferred_element_type=jnp.float32) * scale
        p_win = _masked_softmax(s_win, m_win)
        o_win = jnp.einsum('bgrqk,bkgd->bqgrd', p_win.astype(vw.dtype), vw)
        return gc[..., 0:1] * o_cmp + gc[..., 1:2] * o_sel + gc[..., 2:3] * o_win

    out = lax.map(chunk, jnp.arange(S // QC))
    return jnp.swapaxes(out, 0, 1).reshape(B, S, H * dk)


def _causal_attention(q, k, v):
    B, S, H, dk = q.shape
    dv = v.shape[-1]
    scale = dk ** -0.5
    kpos = jnp.arange(S)

    def block(c):
        s0 = c * ATTN_BLOCK
        qb = lax.dynamic_slice_in_dim(q, s0, ATTN_BLOCK, axis=1)
        s = jnp.einsum('bqhd,bkhd->bhqk', qb, k, preferred_element_type=jnp.float32) * scale
        mask = kpos[None, :] <= (s0 + jnp.arange(ATTN_BLOCK))[:, None]
        p = _masked_softmax(s, mask)
        return jnp.einsum('bhqk,bkhd->bqhd', p.astype(v.dtype), v)

    out = lax.map(block, jnp.arange(S // ATTN_BLOCK))
    return jnp.swapaxes(out, 0, 1).reshape(B, S, H, dv)


def _mla(c_q, c_kv, k_rope, q_norm, w_q_up, kv_norm, w_kv_up, cos, sin):
    B, S, _ = c_q.shape
    q = (_rms_norm(c_q, q_norm) @ w_q_up).reshape(B, S, MLA_HEADS, MLA_NOPE_DIM + MLA_ROPE_DIM)
    q = jnp.concatenate([q[..., :MLA_NOPE_DIM], _rope(q[..., MLA_NOPE_DIM:], cos, sin)], axis=-1)
    kv = (_rms_norm(c_kv, kv_norm) @ w_kv_up).reshape(B, S, MLA_HEADS, MLA_NOPE_DIM + MLA_V_DIM)
    k_nope, v = kv[..., :MLA_NOPE_DIM], kv[..., MLA_NOPE_DIM:]
    k_pe = _rope(k_rope[:, :, None, :], cos, sin)
    k = jnp.concatenate([k_nope, jnp.broadcast_to(k_pe, (B, S, MLA_HEADS, MLA_ROPE_DIM))], axis=-1)
    return _causal_attention(q, k, v).reshape(B, S, MLA_WIDTH)


def setup_inputs(seed: int = 0) -> dict:
    key = jax.random.key(seed)
    ks = jax.random.split(key, 20)
    L = DEPTH
    dk = NSA_HEAD_DIM

    def dense(k, shape, fan_in):
        return jax.random.normal(k, shape, jnp.float32) * fan_in ** -0.5

    def gain(k, shape):
        return 1.0 + 0.02 * jax.random.normal(k, shape, jnp.float32)

    return {
        "x": jax.random.normal(ks[0], (BATCH, SEQ, D_MODEL), jnp.float32),
        "attn_norm": gain(ks[1], (L, D_MODEL)),
        "w_in": dense(ks[2], (L, D_MODEL, IN_WIDTH), D_MODEL),
        "cmp_pos_k": 0.1 * jax.random.normal(ks[3], (L, CMP_BLOCK, dk), jnp.float32),
        "cmp_w1_k": dense(ks[4], (L, CMP_BLOCK * dk, CMP_HIDDEN), CMP_BLOCK * dk),
        "cmp_w2_k": dense(ks[5], (L, CMP_HIDDEN, dk), CMP_HIDDEN),
        "cmp_pos_v": 0.1 * jax.random.normal(ks[6], (L, CMP_BLOCK, dk), jnp.float32),
        "cmp_w1_v": dense(ks[7], (L, CMP_BLOCK * dk, CMP_HIDDEN), CMP_BLOCK * dk),
        "cmp_w2_v": dense(ks[8], (L, CMP_HIDDEN, dk), CMP_HIDDEN),
        "mla_q_norm": gain(ks[9], (L, Q_LORA_RANK)),
        "w_q_up": dense(ks[10], (L, Q_LORA_RANK, MLA_HEADS * (MLA_NOPE_DIM + MLA_ROPE_DIM)), Q_LORA_RANK),
        "mla_kv_norm": gain(ks[11], (L, KV_LORA_RANK)),
        "w_kv_up": dense(ks[12], (L, KV_LORA_RANK, MLA_HEADS * (MLA_NOPE_DIM + MLA_V_DIM)), KV_LORA_RANK),
        "nsa_out_norm": gain(ks[13], (L, NSA_WIDTH)),
        "mla_out_norm": gain(ks[14], (L, MLA_WIDTH)),
        "w_out": dense(ks[15], (L, MIX_WIDTH, D_MODEL), MIX_WIDTH),
        "mlp_norm": gain(ks[16], (L, D_MODEL)),
        "w_ff1": dense(ks[17], (L, D_MODEL, D_FF), D_MODEL),
        "w_ff2": dense(ks[18], (L, D_FF, D_MODEL), D_FF),
        "final_norm": gain(ks[19], (D_MODEL,)),
    }


def reference(x, attn_norm, w_in, cmp_pos_k, cmp_w1_k, cmp_w2_k, cmp_pos_v, cmp_w1_v, cmp_w2_v,
              mla_q_norm, w_q_up, mla_kv_norm, w_kv_up, nsa_out_norm, mla_out_norm, w_out,
              mlp_norm, w_ff1, w_ff2, final_norm):
    B, S, _ = x.shape
    cos_a, sin_a = _rope_tables(S, NSA_HEAD_DIM, x.dtype)
    cos_b, sin_b = _rope_tables(S, MLA_ROPE_DIM, x.dtype)
    offsets = [int(o) for o in np.cumsum(IN_SIZES)[:-1]]
    G = NSA_KV_GROUPS
    for l in range(DEPTH):
        h = _rms_norm(x, attn_norm[l])
        proj = h @ w_in[l]
        (q_a, k_c, v_c, k_s, v_s, k_w, v_w, g_a, c_q, c_kv, k_r) = jnp.split(proj, offsets, axis=-1)
        q_a = _rope(_heads(q_a, NSA_HEADS), cos_a, sin_a)
        k_cmp = _compress(_rope(_heads(k_c, G), cos_a, sin_a), cmp_pos_k[l], cmp_w1_k[l], cmp_w2_k[l])
        v_cmp = _compress(_heads(v_c, G), cmp_pos_v[l], cmp_w1_v[l], cmp_w2_v[l])
        gates = jax.nn.sigmoid(g_a).reshape(B, S, NSA_HEADS, NSA_BRANCHES)
        o_a = _nsa(q_a, k_cmp, v_cmp,
                   _rope(_heads(k_s, G), cos_a, sin_a), _heads(v_s, G),
                   _rope(_heads(k_w, G), cos_a, sin_a), _heads(v_w, G), gates)
        o_b = _mla(c_q, c_kv, k_r, mla_q_norm[l], w_q_up[l], mla_kv_norm[l], w_kv_up[l], cos_b, sin_b)
        mixed = jnp.concatenate([_rms_norm(o_a, nsa_out_norm[l]), _rms_norm(o_b, mla_out_norm[l])], axis=-1)
        x = x + mixed @ w_out[l]
        h = _rms_norm(x, mlp_norm[l])
        x = x + jnp.square(jax.nn.relu(h @ w_ff1[l])) @ w_ff2[l]
    return _rms_norm(x, final_norm)
```

```cpp
#define MK_DEBUG 0
#include <hip/hip_runtime.h>
#include <cstdint>
#include <cstddef>
#define LAS __attribute__((address_space(3)))
#define GAS __attribute__((address_space(1)))
#define DI __device__ __forceinline__

typedef unsigned short bf16_t;
typedef short bf16x8 __attribute__((ext_vector_type(8)));
typedef short s16x4 __attribute__((ext_vector_type(4)));
typedef short v4i16_t __attribute__((ext_vector_type(4)));
typedef float f32x2 __attribute__((ext_vector_type(2)));
typedef float f32x4 __attribute__((ext_vector_type(4)));
typedef float f32x16 __attribute__((ext_vector_type(16)));
typedef unsigned u32x2 __attribute__((ext_vector_type(2)));
typedef unsigned u32x4 __attribute__((ext_vector_type(4)));
typedef __bf16 bf16x2_t __attribute__((ext_vector_type(2)));

namespace mk {

constexpr int D_MODEL = 1024, BATCH = 8, SEQ = 4096, DEPTH = 4, NTOK = BATCH * SEQ, IN_WIDTH = 1720, D_FF = 4096;
constexpr int NPROJ = 1792, NUP = 1792, KUP = 384;
constexpr float NORM_EPS = 1e-6f;
constexpr float LOG2E = 1.4426950408889634f;
constexpr float QS_NSA = 0.125f * LOG2E;
constexpr float QS_MLA = 0.10206207261596575f * LOG2E;
constexpr int NWAVES = 8, NTHR = 512;

constexpr size_t MiB = 1u << 20;
constexpr size_t WS_CTL = 0, CTL_BYTES = 4 * MiB;
constexpr int CW_BAR = 4096;
constexpr int CW_QUEUE = 8192;
constexpr size_t WS_SSCQ = 1 * MiB  , WS_SSCKV = 1 * MiB + 512 * 1024  , WS_SS1 = 492 * MiB  , WS_SS2 = 494 * MiB  ,
                 WS_SSA = 2 * MiB  , WS_SSB = 3 * MiB  ;
constexpr size_t WS_W = 4 * MiB;
constexpr size_t W_WIN = 0, W_W1K = 14 * MiB, W_W1V = 18 * MiB, W_WUP = 22 * MiB  , W_WOUT = 28 * MiB, W_WFF1 = 36 * MiB, W_WFF2 = 68 * MiB;
constexpr size_t SZ_WIN = (size_t)NPROJ * 1024 * 2, SZ_W1 = (size_t)256 * 2048 * 2, SZ_WUP = (size_t)NUP * KUP * 2, SZ_WOUT = (size_t)1024 * 1024 * 2, SZ_WFF = (size_t)4096 * 1024 * 2;
constexpr size_t W_TAB = 100 * MiB;
constexpr size_t W_COSA = W_TAB, W_SINA = W_TAB + 512 * 1024, W_COSB = W_TAB + 1024 * 1024, W_SINB = W_TAB + 1280 * 1024, W_BIAS1 = W_TAB + 1536 * 1024;
constexpr size_t WS_XB = 106 * MiB;
constexpr size_t WS_OAB = 170 * MiB;
constexpr size_t WS_KCMP = 234 * MiB, WS_VCMP = 234 * MiB + 512 * 1024;
constexpr size_t WS_A = 236 * MiB;
constexpr size_t KVSLOT = 8 * MiB + 64 * 1024;
constexpr size_t A_QA = 0, A_KC = 32 * MiB, A_VC = A_KC + KVSLOT, A_KS = A_VC + KVSLOT, A_VS = A_KS + KVSLOT, A_KW = A_VS + KVSLOT, A_VW = A_KW + KVSLOT;
constexpr size_t A_GATES = 81 * MiB, A_CQKV = 84 * MiB  , A_KR = 108 * MiB  , A_QM = 110 * MiB  , A_KN = 158 * MiB, A_VM = 190 * MiB, A_HIDC = 222 * MiB  ;
constexpr size_t A_MIX = A_QM;
constexpr size_t WS_END = WS_A + 256 * MiB + 4 * MiB;
static_assert(WS_W + W_TAB + 2 * MiB <= WS_XB && WS_XB + 64 * MiB <= WS_OAB && WS_OAB + 64 * MiB <= WS_KCMP && WS_VCMP + 512 * 1024 <= WS_A && WS_SS1 == WS_A + 256 * MiB, "ws map");
static_assert(A_VW + KVSLOT <= A_GATES && A_HIDC + 32 * MiB <= 256 * MiB, "A map");

constexpr int LDS_SCRATCH = 131072, LDS_MISC = 131072, LDS_BYTES = 147456;

struct Params {
    const float* in[20];
    float* out;
    unsigned char* ws;
    int s_lo, s_hi;
};

DI unsigned cvtpk(float lo, float hi) { f32x2 v = {lo, hi}; bf16x2_t b = __builtin_convertvector(v, bf16x2_t); return __builtin_bit_cast(unsigned, b); }
DI float bf2f(bf16_t v) { return __builtin_bit_cast(float, (unsigned)v << 16); }
DI float ex2(float x) { return __builtin_amdgcn_exp2f(x); }
DI float wsum(float v) {
#pragma unroll
    for (int o = 1; o < 64; o <<= 1) v += __shfl_xor(v, o);
    return v;
}
DI int crow(int i, int h) { return (i & 3) + 8 * (i >> 2) + 4 * h; }
DI unsigned char* launder(unsigned char* p) { asm volatile("" : "+s"(p)); return p; }
DI const float* launder(const float* p) { asm volatile("" : "+s"(p)); return p; }
DI int launder_v(int v) { asm volatile("" : "+v"(v)); return v; }
DI int launder_s(int v) { asm volatile("" : "+s"(v)); return v; }
DI int lane_id_now() { int l; asm volatile("v_mbcnt_lo_u32_b32 %0, -1, 0\n\tv_mbcnt_hi_u32_b32 %0, -1, %0" : "=v"(l)); return l; }

#define XB_TMO      128
#define XB_XCNT(j)  (256  + 64 * (j))
#define XB_XSUB(j)  (1280 + 64 * (j))
#define XB_XGEN(j)  (2304 + 64 * (j))
#define XB_TOP      3328
#define XB_TOPGEN   3392
#define XCD_BAR_WORDS 3456
#define XB_SPIN_CAP (1u << 20)
DI unsigned xb_ld(unsigned* p)              { return __hip_atomic_load(p, __ATOMIC_RELAXED, __HIP_MEMORY_SCOPE_AGENT); }
DI unsigned xb_add(unsigned* p, unsigned v) { return __hip_atomic_fetch_add(p, v, __ATOMIC_RELAXED, __HIP_MEMORY_SCOPE_AGENT); }
DI unsigned xb_xcc_id() { return (unsigned)__builtin_amdgcn_s_getreg((3 << 11) | 20) & 0xFu; }
#define XB_SPIN(cond, bar) do { unsigned _sp = 0; while (cond) { __builtin_amdgcn_s_sleep(10); \
    if ((++_sp & 255u) == 0u) { if (xb_ld(&(bar)[XB_TMO])) break; if (_sp > XB_SPIN_CAP) { atomicAdd(&(bar)[XB_TMO], 1u); break; } } } } while (0)
struct XcdBarrier { unsigned* bar; unsigned x; volatile LAS unsigned* st; int wave; };
DI XcdBarrier xcd_barrier_post(unsigned* bar, volatile LAS unsigned* st) {
    XcdBarrier b; b.bar = bar; b.x = xb_xcc_id(); b.st = st; b.wave = __builtin_amdgcn_readfirstlane((int)threadIdx.x >> 6);
    if (threadIdx.x == 0) (void)xb_add(&bar[XB_XCNT(b.x)], 1u);
    return b;
}
DI void xcd_barrier_complete(unsigned* bar, unsigned x_, unsigned& nloc, unsigned& nx) {
    unsigned x = x_; asm volatile("" : "+s"(x));
    const unsigned G = gridDim.x * gridDim.y * gridDim.z;
    unsigned sum, cnt, mine, sp = 0u;
    for (;;) {
        sum = 0u; cnt = 0u; mine = 0u;
#pragma unroll
        for (unsigned j = 0; j < 16; ++j) { const unsigned c = xb_ld(&bar[XB_XCNT(j)]); sum += c; cnt += (c > 0u) ? 1u : 0u; mine = (j == x) ? c : mine; }
        if (sum == G) break;
        __builtin_amdgcn_s_sleep(1);
        if ((++sp & 255u) == 0u) { if (xb_ld(&bar[XB_TMO])) break; if (sp > XB_SPIN_CAP) { atomicAdd(&bar[XB_TMO], 1u); break; } }
    }
    nloc = mine > 0u ? mine : 1u; nx = cnt > 0u ? cnt : 1u;
}
DI void xcd_barrier(const XcdBarrier& b) {
    asm volatile("s_waitcnt vmcnt(0)" ::: "memory");
    __syncthreads();
    int wv_ = b.wave; asm volatile("" : "+s"(wv_));
    if (wv_ == 0 && lane_id_now() == 0) {
        unsigned* bar = (unsigned*)launder((unsigned char*)b.bar);
        __builtin_amdgcn_s_waitcnt(0);
        unsigned nloc = b.st[0], nx = b.st[1];
        if (nloc == 0u) { xcd_barrier_complete(bar, b.x, nloc, nx); b.st[0] = nloc; b.st[1] = nx; }
        const unsigned old = xb_add(&bar[XB_XSUB(b.x)], 1u);
        const unsigned gen = old / nloc;
        if (old + 1u == (gen + 1u) * nloc) {
            __builtin_amdgcn_fence(__ATOMIC_RELEASE, "agent");
            asm volatile("s_waitcnt vmcnt(0)" ::: "memory");
            const unsigned og = xb_add(&bar[XB_TOP], 1u);
            const unsigned tg = og / nx;
            if (og + 1u == (tg + 1u) * nx) xb_add(&bar[XB_TOPGEN], 1u);
            else XB_SPIN(xb_ld(&bar[XB_TOPGEN]) == tg, bar);
            __builtin_amdgcn_fence(__ATOMIC_ACQUIRE, "agent");
            xb_add(&bar[XB_XGEN(b.x)], 1u);
            asm volatile("s_waitcnt vmcnt(0)" ::: "memory");
        } else {
            XB_SPIN(xb_ld(&bar[XB_XGEN(b.x)]) == gen, bar);
            __builtin_amdgcn_fence(__ATOMIC_ACQUIRE, "agent");
            asm volatile("s_waitcnt vmcnt(0)" ::: "memory");
        }
    }
    __syncthreads();
}

namespace pg8 {
constexpr int BM = 256, BK = 64, HALF = 128, HTB = HALF * BK * 2, STAGE_BYTES = 8 * HTB, NXCD = 8, WGM = 8;
DI int lds_byte(int r, int c) { const int st = (r >> 4) * 2 + (c >> 5), rr = r & 15, cc = c & 31, ob = rr * 64 + cc * 2; return st * 1024 + (ob ^ (((ob >> 9) & 1) << 5)); }
DI int perm32(int rho) { const int n = rho >> 4, i = rho & 15; return 8 * (i >> 2) + 4 * n + (i & 3); }
DI void stage_rc(int b, int& R, int& C) { const int st = b / 1024, sb = b % 1024, swz = sb ^ (((sb >> 9) & 1) << 5); R = (st >> 1) * 16 + swz / 64; C = (st & 1) * 32 + (swz % 64) / 2; }
struct Unit { int pm, pn; };
struct Gemm { const bf16_t* A; const bf16_t* Bt; int M, N, K, lda, ldb; };
struct StaticOrder {
    int nM, nN, nwg, G, c;
    DI void init(int M, int N, int G_, int c_) { nM = M / BM; nN = N / BM; nwg = nM * nN; G = G_; c = c_; }
    DI bool next(int i, Unit& u) const {
        const long L = (long)i * G + c; if (c < 0 || L >= nwg) return false;
        int wgid = (int)L; { const int q = nwg / NXCD, r = nwg % NXCD, xcd = wgid % NXCD, off = wgid / NXCD; wgid = (xcd < r ? xcd * (q + 1) : r * (q + 1) + (xcd - r) * q) + off; }
        const int nig = WGM * nN, gid = wgid / nig, fm = gid * WGM, gsz = (nM - fm) < WGM ? (nM - fm) : WGM;
        u.pm = fm + ((wgid % nig) % gsz); u.pn = (wgid % nig) / gsz; return true;
    }
};

template <class Epi, class Sched>
DI void gemm_phase(LAS unsigned char* lds, const Gemm g, const Sched& S, const Epi& E, int wave0) {
    const int lane = lane_id_now(), wid = wave0, tid = wid * 64 + lane, wr = wid >> 2, wc = wid & 3, fr = lane & 15, fq = lane >> 4;
    const int K = g.K, nt = K / BK;
    unsigned voffA[2], voffB[2];
#pragma unroll
    for (int i = 0; i < 2; ++i) { int R, C; stage_rc(tid * 16 + i * 8192, R, C);
        const int g_ = R >> 5, Rb = Epi::PERM == 2 ? ((g_ & 3) * 64 + (g_ >> 2) * 32 + perm32(R & 31))
                                   : Epi::PERM ? ((R & ~31) + perm32(R & 31)) : R;
        voffA[i] = (unsigned)(R * g.lda + C) * 2u; voffB[i] = (unsigned)(Rb * g.ldb + C) * 2u; }
    const size_t kstep = (size_t)(BK * 2);
    const size_t hstepA = (size_t)HALF * g.lda * 2, hstepB = (size_t)(Epi::PERM == 2 ? 32 : HALF) * g.ldb * 2;
    const size_t tstepA = 2 * hstepA, tstepB = (size_t)2 * HALF * g.ldb * 2;
    const unsigned ldsw = (unsigned)wid * 1024u;
    const int aoff = lds_byte(wr * 64 + fr, fq * 8), boff = lds_byte(wc * 32 + fr, fq * 8);
#define PG8_SA(b, h) (((b) * 2 + (h)) * HTB)
#define PG8_SB(b, h) ((4 + (b) * 2 + (h)) * HTB)
#define PG8_STAGE(bufoff, gbase, voff) do { _Pragma("unroll") for (int _i = 0; _i < 2; ++_i) \
        __builtin_amdgcn_global_load_lds((const unsigned*)((const char*)(gbase) + (voff)[_i]), (LAS unsigned*)(lds + (bufoff) + ldsw + _i * 8192), 16, 0, 0); } while (0)
#define PG8_LDA(dst, b, h) do { _Pragma("unroll") for (int m = 0; m < 4; ++m) _Pragma("unroll") for (int k = 0; k < 2; ++k) dst[m][k] = *(const LAS bf16x8*)(lds + PG8_SA(b, h) + aoff + m * 2048 + k * 1024); } while (0)
#define PG8_LDB(dst, b, h) do { _Pragma("unroll") for (int n = 0; n < 2; ++n) _Pragma("unroll") for (int k = 0; k < 2; ++k) dst[n][k] = *(const LAS bf16x8*)(lds + PG8_SB(b, h) + boff + n * 2048 + k * 1024); } while (0)
#define PG8_MMA(ai, bj, At, Bt) do { __builtin_amdgcn_s_setprio(1); _Pragma("unroll") for (int m = 0; m < 4; ++m) _Pragma("unroll") for (int n = 0; n < 2; ++n) _Pragma("unroll") for (int k = 0; k < 2; ++k) \
        acc[ai][bj][m][n] = __builtin_amdgcn_mfma_f32_16x16x32_bf16(Bt[n][k], At[m][k], acc[ai][bj][m][n], 0, 0, 0); __builtin_amdgcn_s_setprio(0); } while (0)
#define PG8_WAIT_V(n) asm volatile("s_waitcnt vmcnt(" #n ")" ::: "memory")
#define PG8_WAIT_L(n) asm volatile("s_waitcnt lgkmcnt(" #n ")" ::: "memory")
#define PG8_BAR __builtin_amdgcn_s_barrier()
#define PG8_SCHED __builtin_amdgcn_sched_barrier(0)
    Unit cur, nxt; int ui = 0;
    if (!S.next(0, cur)) return;
    f32x4 acc[2][2][4][2];
#pragma unroll
    for (int a = 0; a < 2; ++a)
#pragma unroll
        for (int b = 0; b < 2; ++b)
#pragma unroll
            for (int m = 0; m < 4; ++m)
#pragma unroll
                for (int n = 0; n < 2; ++n) acc[a][b][m][n] = (f32x4){0.f, 0.f, 0.f, 0.f};
    bf16x8 At[4][2], B0[2][2], B1[2][2];
    const char* cA = (const char*)g.A + (size_t)cur.pm * tstepA; const char* cB = (const char*)g.Bt + (size_t)cur.pn * tstepB;
    PG8_STAGE(PG8_SB(0, 0), cB, voffB); PG8_STAGE(PG8_SB(0, 1), cB + hstepB, voffB); PG8_STAGE(PG8_SA(0, 0), cA, voffA); PG8_STAGE(PG8_SA(0, 1), cA + hstepA, voffA);
    if (wr == 1) PG8_BAR;
    PG8_WAIT_V(2); PG8_BAR;
    PG8_STAGE(PG8_SB(1, 0), cB + kstep, voffB); PG8_STAGE(PG8_SA(1, 0), cA + kstep, voffA); PG8_STAGE(PG8_SB(1, 1), cB + hstepB + kstep, voffB);
    PG8_WAIT_V(6); PG8_BAR;
    for (;;) {
        const bool has_next = S.next(ui + 1, nxt);
        const char* nA = has_next ? (const char*)g.A + (size_t)nxt.pm * tstepA : cA; const char* nB = has_next ? (const char*)g.Bt + (size_t)nxt.pn * tstepB : cB;
#pragma unroll 1
        for (int t = 0; t < nt; t += 2) {
            if constexpr (Epi::MID) { if (t == nt / 2) E.mid(acc, cur, wr, wc, fr, fq); }
            const bool last = (t == nt - 2);
            const char* a1 = cA + (size_t)(t + 1) * kstep;
            const char* a2 = last ? nA : cA + (size_t)(t + 2) * kstep; const char* b2 = last ? nB : cB + (size_t)(t + 2) * kstep;
            const char* a3 = a2 + kstep; const char* b3 = b2 + kstep;
            PG8_LDB(B0, 0, 0); PG8_LDB(B1, 0, 1); PG8_SCHED; PG8_LDA(At, 0, 0); PG8_STAGE(PG8_SA(1, 1), a1 + hstepA, voffA);
            PG8_WAIT_V(8); PG8_WAIT_L(0); PG8_BAR; PG8_MMA(0, 0, At, B0); PG8_MMA(0, 1, At, B1); PG8_BAR; PG8_SCHED;
            PG8_LDA(At, 0, 1); PG8_STAGE(PG8_SB(0, 0), b2, voffB); PG8_STAGE(PG8_SB(0, 1), b2 + hstepB, voffB); PG8_STAGE(PG8_SA(0, 0), a2, voffA);
            PG8_WAIT_V(8); PG8_WAIT_L(0); PG8_BAR; PG8_MMA(1, 0, At, B0); PG8_MMA(1, 1, At, B1); PG8_BAR; PG8_SCHED;
            PG8_LDB(B0, 1, 0); PG8_LDB(B1, 1, 1); PG8_SCHED; PG8_LDA(At, 1, 0); PG8_STAGE(PG8_SA(0, 1), a2 + hstepA, voffA);
            PG8_WAIT_V(8); PG8_WAIT_L(0); PG8_BAR; PG8_MMA(0, 0, At, B0); PG8_MMA(0, 1, At, B1); PG8_BAR; PG8_SCHED;
            PG8_LDA(At, 1, 1); PG8_STAGE(PG8_SB(1, 0), b3, voffB); PG8_STAGE(PG8_SB(1, 1), b3 + hstepB, voffB); PG8_STAGE(PG8_SA(1, 0), a3, voffA);
            PG8_WAIT_V(8); PG8_WAIT_L(0); PG8_BAR; PG8_MMA(1, 0, At, B0); PG8_MMA(1, 1, At, B1); PG8_BAR; PG8_SCHED;
        }
        if (wr == 0) PG8_BAR;
        E(acc, cur, wr, wc, fr, fq);
#ifdef MK_EPI2
        if constexpr (Epi::EPI2) E(acc, cur, wr, wc, fr, fq);
#endif
        if (!has_next) break;
#pragma unroll
        for (int a = 0; a < 2; ++a)
#pragma unroll
            for (int b = 0; b < 2; ++b)
#pragma unroll
                for (int m = 0; m < 4; ++m)
#pragma unroll
                    for (int n = 0; n < 2; ++n) acc[a][b][m][n] = (f32x4){0.f, 0.f, 0.f, 0.f};
        cur = nxt; cA = nA; cB = nB; ++ui;
        if (wr == 1) PG8_BAR;
    }
    PG8_WAIT_V(0);
    PG8_BAR;
#undef PG8_SA
#undef PG8_SB
#undef PG8_STAGE
#undef PG8_LDA
#undef PG8_LDB
#undef PG8_MMA
#undef PG8_WAIT_V
#undef PG8_WAIT_L
#undef PG8_BAR
#undef PG8_SCHED
}
}

using pg8::Unit;
typedef f32x4 AccT[2][2][4][2];

DI void st_bf4(bf16_t* p, f32x4 v) { u32x2 w; w.x = cvtpk(v[0], v[1]); w.y = cvtpk(v[2], v[3]); *(GAS u32x2*)p = w; }
DI float sq4(f32x4 v) { return (v[0] * v[0] + v[1] * v[1]) + (v[2] * v[2] + v[3] * v[3]); }
DI float st_bf4_sq(bf16_t* p, f32x4 v) { u32x2 w; w.x = cvtpk(v[0], v[1]); w.y = cvtpk(v[2], v[3]); *(GAS u32x2*)p = w;
    const float a = __builtin_bit_cast(float, w[0] << 16), b = __builtin_bit_cast(float, w[0] & 0xffff0000u), c = __builtin_bit_cast(float, w[1] << 16), d = __builtin_bit_cast(float, w[1] & 0xffff0000u);
    return (a * a + b * b) + (c * c + d * d); }
DI float st_row64(bf16_t* rowp, const f32x16& o0, const f32x16& o1, float scale, int h) {
    float ssq = 0.f; u32x2 pc[8];
#pragma unroll
    for (int g = 0; g < 8; ++g) { const f32x16& o = g < 4 ? o0 : o1; const int b4 = (g & 3) * 4;
        u32x2 w; w.x = cvtpk(o[b4] * scale, o[b4 + 1] * scale); w.y = cvtpk(o[b4 + 2] * scale, o[b4 + 3] * scale); pc[g] = w;
        const float a = __builtin_bit_cast(float, w[0] << 16), b = __builtin_bit_cast(float, w[0] & 0xffff0000u), c = __builtin_bit_cast(float, w[1] << 16), d = __builtin_bit_cast(float, w[1] & 0xffff0000u);
        ssq += (a * a + b * b) + (c * c + d * d); }
#pragma unroll
    for (int k = 0; k < 4; ++k) {
        const u32x2 snd = h ? pc[2 * k] : pc[2 * k + 1]; u32x2 rcv;
        rcv.x = (unsigned)__shfl_xor((int)snd.x, 32); rcv.y = (unsigned)__shfl_xor((int)snd.y, 32);
        u32x4 out; if (h) { out.x = rcv.x; out.y = rcv.y; out.z = pc[2 * k + 1].x; out.w = pc[2 * k + 1].y; } else { out.x = pc[2 * k].x; out.y = pc[2 * k].y; out.z = rcv.x; out.w = rcv.y; }
        *(GAS u32x4*)(rowp + 16 * k + (h ? 8 : 0)) = out; }
    return ssq;
}
DI float sum16(const float* p) { const f32x4 a = *(const GAS f32x4*)p, b = *(const GAS f32x4*)(p + 4), c = *(const GAS f32x4*)(p + 8), d = *(const GAS f32x4*)(p + 12);
    return (((a[0] + a[1]) + (a[2] + a[3])) + ((b[0] + b[1]) + (b[2] + b[3]))) + (((c[0] + c[1]) + (c[2] + c[3])) + ((d[0] + d[1]) + (d[2] + d[3]))); }
DI float sum4(const float* p) { const f32x4 a = *(const GAS f32x4*)p; return (a[0] + a[1]) + (a[2] + a[3]); }

DI void st_bf8(bf16_t* p, f32x4 a, f32x4 b) { u32x4 w; w.x = cvtpk(a[0], a[1]); w.y = cvtpk(a[2], a[3]); w.z = cvtpk(b[0], b[1]); w.w = cvtpk(b[2], b[3]); *(GAS u32x4*)p = w; }
struct EpiInProj {
    static constexpr bool MID = false; static constexpr bool EPI2 = false; static constexpr bool PERM = true;
    unsigned char* ws_; int l;
    DI void operator()(const AccT& acc, const Unit& u, int wr, int wc, int fr, int fq) const {
        unsigned char* ws = launder(ws_);
        unsigned char* A = ws + WS_A;
        const float* ss1 = (const float*)(ws + WS_SS1); float* sscq = (float*)(ws + WS_SSCQ); float* ssckv = (float*)(ws + WS_SSCKV);
        bf16_t* QA = (bf16_t*)(A + A_QA); bf16_t* KC = (bf16_t*)(A + A_KC); bf16_t* VC = (bf16_t*)(A + A_VC); bf16_t* CQKV = (bf16_t*)(A + A_CQKV); bf16_t* KR = (bf16_t*)(A + A_KR); float* GATES = (float*)(A + A_GATES);
        const float* cosA = (const float*)(ws + WS_W + W_COSA); const float* sinA = (const float*)(ws + WS_W + W_SINA); const float* cosB = (const float*)(ws + WS_W + W_COSB); const float* sinB = (const float*)(ws + WS_W + W_SINB);
        const int pn = u.pn;
#pragma unroll
        for (int ai = 0; ai < 2; ++ai)
#pragma unroll
            for (int m = 0; m < 4; ++m) {
                const int row = u.pm * 256 + ai * 128 + wr * 64 + m * 16 + fr, t = row & (SEQ - 1), b = row >> 12;
                const float rstd = rsqrtf(sum16(ss1 + (size_t)row * 16) * (1.0f / 1024.0f) + NORM_EPS);
                if (pn < 5) {
                    const bool roped = pn < 2 || wc < 2;
                    if (roped) {
                        const f32x4 c0 = *(const GAS f32x4*)(cosA + t * 32 + 8 * fq), c1 = *(const GAS f32x4*)(cosA + t * 32 + 8 * fq + 4);
                        const f32x4 s0 = *(const GAS f32x4*)(sinA + t * 32 + 8 * fq), s1 = *(const GAS f32x4*)(sinA + t * 32 + 8 * fq + 4);
                        const f32x4 l0 = acc[ai][0][m][0] * rstd, l1 = acc[ai][0][m][1] * rstd, h0 = acc[ai][1][m][0] * rstd, h1 = acc[ai][1][m][1] * rstd;
                        bf16_t* dst; float sc;
                        if (pn < 2) { dst = QA + (size_t)row * 512 + (pn * 4 + wc) * 64 + 8 * fq; sc = QS_NSA; }
                        else { dst = KC + (size_t)(pn - 2) * KVSLOT + ((size_t)(b * 2 + wc) * SEQ + t) * 64 + 8 * fq; sc = 1.0f; }
                        st_bf8(dst, (l0 * c0 - h0 * s0) * sc, (l1 * c1 - h1 * s1) * sc);
                        st_bf8(dst + 32, (h0 * c0 + l0 * s0) * sc, (h1 * c1 + l1 * s1) * sc);
                    } else {
                        bf16_t* dst = VC + (size_t)(pn - 2) * KVSLOT + ((size_t)(b * 2 + (wc - 2)) * SEQ + t) * 64 + 8 * fq;
                        st_bf8(dst, acc[ai][0][m][0] * rstd, acc[ai][0][m][1] * rstd);
                        st_bf8(dst + 32, acc[ai][1][m][0] * rstd, acc[ai][1][m][1] * rstd);
                    }
                } else if (pn == 5) {
                    float q = 0.f;
#pragma unroll
                    for (int bj = 0; bj < 2; ++bj) { const f32x4 x0 = acc[ai][bj][m][0] * rstd, x1 = acc[ai][bj][m][1] * rstd; q += sq4(x0) + sq4(x1); st_bf8(CQKV + (size_t)row * KUP + bj * 128 + wc * 32 + 8 * fq, x0, x1); }
                    q += __shfl_xor(q, 16); q += __shfl_xor(q, 32);
                    if (fq == 0) sscq[(size_t)row * 4 + wc] = q;
                } else {
                    { const f32x4 x0 = acc[ai][0][m][0] * rstd, x1 = acc[ai][0][m][1] * rstd; float q = sq4(x0) + sq4(x1); st_bf8(CQKV + (size_t)row * KUP + 256 + wc * 32 + 8 * fq, x0, x1);
                      q += __shfl_xor(q, 16); q += __shfl_xor(q, 32);
                      if (fq == 0) ssckv[(size_t)row * 4 + wc] = q; }
                    if (wc == 0) {
                        const f32x4 c4 = *(const GAS f32x4*)(cosB + t * 16 + 4 * fq), s4 = *(const GAS f32x4*)(sinB + t * 16 + 4 * fq);
                        const f32x4 x0 = acc[ai][1][m][0] * rstd, x1 = acc[ai][1][m][1] * rstd;
                        bf16_t* dst = KR + (size_t)row * 32 + 4 * fq;
                        st_bf4(dst, x0 * c4 - x1 * s4); st_bf4(dst + 16, x1 * c4 + x0 * s4);
                    } else if (wc == 1 && fq < 3) {
#pragma unroll
                        for (int n = 0; n < 2; ++n) { const f32x4 x = acc[ai][1][m][n] * rstd; f32x4 sg;
#pragma unroll
                            for (int j = 0; j < 4; ++j) sg[j] = 1.0f / (1.0f + __expf(-x[j]));
                            *(GAS f32x4*)(GATES + (size_t)row * 24 + 8 * fq + 4 * n) = sg; }
                    }
                }
                if (m == 3) asm volatile("" ::: "memory");
            }
    }
};

struct EpiUp {
    static constexpr bool MID = false; static constexpr bool EPI2 = false; static constexpr bool PERM = true;
    unsigned char* ws_; int l;
    DI void operator()(const AccT& acc, const Unit& u, int wr, int wc, int fr, int fq) const {
        unsigned char* ws = launder(ws_);
        unsigned char* A = ws + WS_A;
        const int pn = u.pn;
        const float* ssp = (const float*)(ws + (pn < 3 ? WS_SSCQ : WS_SSCKV));
        const float ssdiv = pn < 3 ? (1.0f / 256.0f) : (1.0f / 128.0f), ssmul = pn < 3 ? QS_MLA : 1.0f;
        const int row0 = u.pm * 256 + wr * 64 + fr;
        if (pn < 2) {
            bf16_t* QM = (bf16_t*)(A + A_QM);
#pragma unroll
            for (int ai = 0; ai < 2; ++ai)
#pragma unroll
                for (int m = 0; m < 4; ++m) { const int row = row0 + ai * 128 + m * 16; const float sc = rsqrtf(sum4(ssp + (size_t)row * 4) * ssdiv + NORM_EPS) * ssmul;
#pragma unroll
                    for (int bj = 0; bj < 2; ++bj) { const int head = pn * 4 + bj * 2 + (wc >> 1);
                        st_bf8(QM + (size_t)row * 768 + head * 96 + 32 * (wc & 1) + 8 * fq, acc[ai][bj][m][0] * sc, acc[ai][bj][m][1] * sc); }
                    if (m == 3) asm volatile("" ::: "memory"); }
        } else if (pn == 2) {
            bf16_t* QM = (bf16_t*)(A + A_QM);
            const float* cosB = (const float*)(ws + WS_W + W_COSB); const float* sinB = (const float*)(ws + WS_W + W_SINB);
#pragma unroll
            for (int ai = 0; ai < 2; ++ai)
#pragma unroll
                for (int m = 0; m < 4; ++m) { const int row = row0 + ai * 128 + m * 16, t = row & (SEQ - 1); const float sc = rsqrtf(sum4(ssp + (size_t)row * 4) * ssdiv + NORM_EPS) * ssmul;
                    const f32x4 c4 = *(const GAS f32x4*)(cosB + t * 16 + 4 * fq), s4 = *(const GAS f32x4*)(sinB + t * 16 + 4 * fq);
#pragma unroll
                    for (int bj = 0; bj < 2; ++bj) { const int hd = bj * 4 + wc;
                        const f32x4 x0 = acc[ai][bj][m][0] * sc, x1 = acc[ai][bj][m][1] * sc;
                        bf16_t* dst = QM + (size_t)row * 768 + hd * 96 + 64 + 4 * fq;
                        st_bf4(dst, x0 * c4 - x1 * s4); st_bf4(dst + 16, x1 * c4 + x0 * s4); }
                    if (m == 3) asm volatile("" ::: "memory"); }
        } else {
            bf16_t* base = (bf16_t*)(A + (pn < 5 ? A_KN : A_VM)); const int pq = (pn < 5) ? pn - 3 : pn - 5;
#pragma unroll
            for (int ai = 0; ai < 2; ++ai)
#pragma unroll
                for (int m = 0; m < 4; ++m) { const int row = row0 + ai * 128 + m * 16, t = row & (SEQ - 1), b = row >> 12; const float sc = rsqrtf(sum4(ssp + (size_t)row * 4) * ssdiv + NORM_EPS);
#pragma unroll
                    for (int bj = 0; bj < 2; ++bj) { const int head = pq * 4 + bj * 2 + (wc >> 1);
                        st_bf8(base + ((size_t)(b * 8 + head) * SEQ + t) * 64 + 32 * (wc & 1) + 8 * fq, acc[ai][bj][m][0] * sc, acc[ai][bj][m][1] * sc); }
                    if (m == 3) asm volatile("" ::: "memory"); }
        }
    }
};

struct EpiSlab {
    static constexpr bool MID = false; static constexpr bool EPI2 = false; static constexpr bool PERM = true;
    unsigned char* ws_; int slab;
    DI void operator()(const AccT& acc, const Unit& u, int wr, int wc, int fr, int fq) const {
        float* S = (float*)(launder(ws_) + WS_A + A_HIDC) + (size_t)slab * 4096 * 256;
#pragma unroll
        for (int ai = 0; ai < 2; ++ai)
#pragma unroll
            for (int m = 0; m < 4; ++m) { const int row = u.pm * 256 + ai * 128 + wr * 64 + m * 16 + fr;
#pragma unroll
                for (int bj = 0; bj < 2; ++bj)
#pragma unroll
                    for (int n = 0; n < 2; ++n) *(GAS f32x4*)(S + (size_t)row * 256 + bj * 128 + wc * 32 + 8 * fq + 4 * n) = acc[ai][bj][m][n]; }
    }
};

template <bool NORM2>
struct EpiResid {
    static constexpr bool MID = NORM2; static constexpr bool EPI2 = false; static constexpr bool PERM = true;
    unsigned char* ws_; int ssi;
    DI static float rstd8(const float* p) { const f32x4 a = *(const GAS f32x4*)p, b = *(const GAS f32x4*)(p + 4);
        return rsqrtf((((a[0] + a[1]) + (a[2] + a[3])) + ((b[0] + b[1]) + (b[2] + b[3]))) * (1.0f / 512.0f) + NORM_EPS); }
    DI void mid(AccT& acc, const Unit& u, int wr, int wc, int fr, int fq) const {
        unsigned char* ws = launder(ws_); const float* ssa = (const float*)(ws + WS_SSA); const float* ssb = (const float*)(ws + WS_SSB);
#pragma unroll
        for (int ai = 0; ai < 2; ++ai)
#pragma unroll
            for (int m = 0; m < 4; ++m) { const int row = u.pm * 256 + ai * 128 + wr * 64 + m * 16 + fr;
                const float ratio = rstd8(ssa + (size_t)row * 8) / rstd8(ssb + (size_t)row * 8);
#pragma unroll
                for (int bj = 0; bj < 2; ++bj)
#pragma unroll
                    for (int n = 0; n < 2; ++n) acc[ai][bj][m][n] *= ratio;
                if (m & 1) asm volatile("" ::: "memory"); }
    }
    DI void operator()(const AccT& acc, const Unit& u, int wr, int wc, int fr, int fq) const {
        unsigned char* ws = launder(ws_);
        bf16_t* XB = (bf16_t*)(ws + WS_XB); float* ss = (float*)(ws + (ssi ? WS_SS2 : WS_SS1)); const float* ssb = (const float*)(ws + WS_SSB);
#pragma unroll
        for (int ai = 0; ai < 2; ++ai) {
            u32x4 old_[4][2]; float sc_[4];
#pragma unroll
            for (int m = 0; m < 4; ++m) { const int row = u.pm * 256 + ai * 128 + wr * 64 + m * 16 + fr;
#pragma unroll
                for (int bj = 0; bj < 2; ++bj) old_[m][bj] = *(const GAS u32x4*)(XB + (size_t)row * 1024 + u.pn * 256 + bj * 128 + wc * 32 + 8 * fq);
                sc_[m] = NORM2 ? rstd8(ssb + (size_t)row * 8) : 1.0f; }
#pragma unroll
            for (int m = 0; m < 4; ++m) { const int row = u.pm * 256 + ai * 128 + wr * 64 + m * 16 + fr; float q = 0.f;
                const float sc = sc_[m];
#pragma unroll
                for (int bj = 0; bj < 2; ++bj) { const size_t off = (size_t)row * 1024 + u.pn * 256 + bj * 128 + wc * 32 + 8 * fq;
                    const u32x4 o = old_[m][bj];
                    f32x4 x0, x1;
                    x0[0] = __builtin_bit_cast(float, o[0] << 16); x0[1] = __builtin_bit_cast(float, o[0] & 0xffff0000u); x0[2] = __builtin_bit_cast(float, o[1] << 16); x0[3] = __builtin_bit_cast(float, o[1] & 0xffff0000u);
                    x1[0] = __builtin_bit_cast(float, o[2] << 16); x1[1] = __builtin_bit_cast(float, o[2] & 0xffff0000u); x1[2] = __builtin_bit_cast(float, o[3] << 16); x1[3] = __builtin_bit_cast(float, o[3] & 0xffff0000u);
                    x0 += NORM2 ? acc[ai][bj][m][0] * sc : acc[ai][bj][m][0]; x1 += NORM2 ? acc[ai][bj][m][1] * sc : acc[ai][bj][m][1];
                    u32x4 w; w.x = cvtpk(x0[0], x0[1]); w.y = cvtpk(x0[2], x0[3]); w.z = cvtpk(x1[0], x1[1]); w.w = cvtpk(x1[2], x1[3]); *(GAS u32x4*)(XB + off) = w;
#pragma unroll
                    for (int j = 0; j < 4; ++j) { const float a = __builtin_bit_cast(float, w[j] << 16), b = __builtin_bit_cast(float, w[j] & 0xffff0000u); q += a * a + b * b; } }
                q += __shfl_xor(q, 16); q += __shfl_xor(q, 32);
                if (fq == 0) ss[(size_t)row * 16 + u.pn * 4 + wc] = q; }
            asm volatile("" ::: "memory"); }
    }
};

struct EpiFF1 {
    static constexpr bool MID = false; static constexpr bool EPI2 = true; static constexpr int PERM = 2;
    unsigned char* ws_; int l;
    mutable float rs_[8]; mutable int pm_ = -1;
    DI void operator()(const AccT& acc, const Unit& u, int wr, int wc, int fr, int fq) const {
        unsigned char* ws = launder(ws_); const float* ss2 = (const float*)(ws + WS_SS2); bf16_t* HID = (bf16_t*)(ws + WS_A);
        if (u.pm != pm_) {
            pm_ = u.pm;
#pragma unroll
            for (int g = 0; g < 8; ++g) { const int row = u.pm * 256 + (g >> 2) * 128 + wr * 64 + (g & 3) * 16 + fr;
                rs_[g] = rsqrtf(sum16(ss2 + (size_t)row * 16) * (1.0f / 1024.0f) + NORM_EPS);
                if ((g & 3) == 3) asm volatile("" ::: "memory"); }
        }
        const bool hi = (fr & 8) != 0;
#pragma unroll
        for (int ai = 0; ai < 2; ++ai)
#pragma unroll
            for (int m = 0; m < 4; ++m) { const int row8 = u.pm * 256 + ai * 128 + wr * 64 + m * 16 + (fr & 7);
                const float rstd = rs_[ai * 4 + m];
                u32x4 w[2];
#pragma unroll
                for (int bj = 0; bj < 2; ++bj) { f32x4 x0 = acc[ai][bj][m][0] * rstd, x1 = acc[ai][bj][m][1] * rstd;
#pragma unroll
                    for (int j = 0; j < 4; ++j) { const float r0 = fmaxf(x0[j], 0.f), r1 = fmaxf(x1[j], 0.f); x0[j] = r0 * r0; x1[j] = r1 * r1; }
                    w[bj].x = cvtpk(x0[0], x0[1]); w[bj].y = cvtpk(x0[2], x0[3]); w[bj].z = cvtpk(x1[0], x1[1]); w[bj].w = cvtpk(x1[2], x1[3]); }
                u32x4 rcv, va, vb;
#pragma unroll
                for (int j = 0; j < 4; ++j) { const unsigned snd = hi ? w[0][j] : w[1][j];
                    rcv[j] = (unsigned)__builtin_amdgcn_update_dpp(0, (int)snd, 0x128, 0xf, 0xf, false);
                    va[j] = hi ? rcv[j] : w[0][j]; vb[j] = hi ? w[1][j] : rcv[j]; }
                bf16_t* dst = HID + (size_t)row8 * D_FF + u.pn * 256 + wc * 64 + (hi ? 32 : 0) + 8 * fq;
                __builtin_nontemporal_store(va, (GAS u32x4*)dst);
                __builtin_nontemporal_store(vb, (GAS u32x4*)(dst + (size_t)8 * D_FF));
                if (m == 3) asm volatile("" ::: "memory"); }
    }
};

DI int rope32_dim(int pos) { return 4 * (pos >> 3) + (pos & 3) + 16 * ((pos >> 2) & 1); }
DI int win_src(int P) {
    const int tile = P >> 8, p = P & 255, bj = p >> 7, wc = (p >> 5) & 3, pos = p & 31;
    if (tile < 2) return (tile * 4 + wc) * 64 + 32 * bj + pos;
    if (tile < 5) { const int base = 512 + (tile - 2) * 256;
        return wc < 2 ? base + wc * 64 + 32 * bj + pos : base + 128 + (wc - 2) * 64 + 32 * bj + pos; }
    if (tile == 5) return 1304 + p;
    if (bj == 0) return 1560 + (p & 127);
    if (wc == 0) return 1688 + rope32_dim(pos);
    if (wc == 1) return pos < 24 ? 1280 + pos : -1;
    return -1;
}
DI int wup_src(int P) {
    const int tile = P >> 8, p = P & 255;
    if (tile < 2) return (tile * 4 + (p >> 6)) * 96 + (p & 63);
    if (tile == 2) return (p >> 5) * 96 + 64 + rope32_dim(p & 31);
    const int q = P - 768;
    if (q < 512) return (q >> 6) * 128 + (q & 63);
    return ((q - 512) >> 6) * 128 + 64 + (q & 63);
}
DI void transpose_item(const float* W, int ldw, const float* gain, int src, bf16_t* WT, int ldwt, int k0w, int k0t, int n0, LAS float* scr, int lane) {
    const int nn = lane & 31, kh = lane >> 5;
    float v[32], gv[32];
#pragma unroll
    for (int i = 0; i < 32; ++i) { const int kk = 2 * i + kh;
        v[i] = src >= 0 ? __builtin_nontemporal_load((const GAS float*)(W + (size_t)(k0w + kk) * ldw + src)) : 0.f;
        gv[i] = gain ? *(const GAS float*)(gain + k0w + kk) : 1.0f; }
#pragma unroll
    for (int i = 0; i < 32; ++i) scr[(2 * i + kh) * 33 + nn] = v[i] * gv[i];
    asm volatile("s_waitcnt lgkmcnt(0)" ::: "memory");
    const int c = lane & 7;
#pragma unroll
    for (int j = 0; j < 4; ++j) { const int n = (lane >> 3) + 8 * j; const LAS float* sp = scr + (8 * c) * 33 + n;
        u32x4 o; o.x = cvtpk(sp[0], sp[33]); o.y = cvtpk(sp[2 * 33], sp[3 * 33]); o.z = cvtpk(sp[4 * 33], sp[5 * 33]); o.w = cvtpk(sp[6 * 33], sp[7 * 33]);
        *(u32x4*)(WT + (size_t)(n0 + n) * ldwt + k0t + 8 * c) = o; }
    asm volatile("s_waitcnt lgkmcnt(0)" ::: "memory");
}

constexpr int U_WIN = 56 * 16, U_W1 = 8 * 32, U_WUP = 56 * 6, U_WOUT = 32 * 16, U_WFF1 = 128 * 16, U_WFF2 = 32 * 64;
constexpr int U_LAYER = U_WIN + 2 * U_W1 + U_WUP + U_WOUT + U_WFF1 + U_WFF2;

DI void convert_weights(const Params& p, LAS unsigned char* lds, int wave, int l_lo, int l_hi, int gw, int NGW) {
    const int lane = lane_id_now();
    unsigned char* ws = launder(p.ws);
    unsigned char* wsw = ws + WS_W;
    LAS float* scr = (LAS float*)lds + wave * (64 * 33);
    const int nn = lane & 31;
    for (int uu = l_lo * U_LAYER + gw; uu < l_hi * U_LAYER; uu += NGW) {
        const int l = uu / U_LAYER; int r = uu % U_LAYER;
        if (r < U_WIN) { const int kt = r / 56, nt = r % 56;
            transpose_item(p.in[2] + (size_t)l * 1024 * IN_WIDTH, IN_WIDTH, p.in[1] + l * 1024, win_src(nt * 32 + nn), (bf16_t*)(wsw + W_WIN + l * SZ_WIN), 1024, kt * 64, kt * 64, nt * 32, scr, lane); continue; }
        r -= U_WIN;
        if (r < U_W1) { const int kt = r / 8, nt = r % 8;
            transpose_item(p.in[4] + (size_t)l * 2048 * 256, 256, nullptr, nt * 32 + nn, (bf16_t*)(wsw + W_W1K + l * SZ_W1), 2048, kt * 64, kt * 64, nt * 32, scr, lane); continue; }
        r -= U_W1;
        if (r < U_W1) { const int kt = r / 8, nt = r % 8;
            transpose_item(p.in[7] + (size_t)l * 2048 * 256, 256, nullptr, nt * 32 + nn, (bf16_t*)(wsw + W_W1V + l * SZ_W1), 2048, kt * 64, kt * 64, nt * 32, scr, lane); continue; }
        r -= U_W1;
        if (r < U_WUP) { const int kt = r / 56, nt = r % 56; const int P = nt * 32 + nn; const bool isq = (nt * 32) < 768;
            bf16_t* WT = (bf16_t*)(wsw + W_WUP + l * SZ_WUP);
            if (isq) transpose_item(p.in[10] + (size_t)l * 256 * 768, 768, p.in[9] + l * 256, kt < 4 ? wup_src(P) : -1, WT, KUP, kt < 4 ? kt * 64 : 0, kt * 64, nt * 32, scr, lane);
            else transpose_item(p.in[12] + (size_t)l * 128 * 1024, 1024, p.in[11] + l * 128, kt >= 4 ? wup_src(P) : -1, WT, KUP, kt >= 4 ? (kt - 4) * 64 : 0, kt * 64, nt * 32, scr, lane);
            continue; }
        r -= U_WUP;
        if (r < U_WOUT) { const int kt = r / 32, nt = r % 32;
            const float* gn = kt < 8 ? p.in[13] + l * 512 : p.in[14] + l * 512 - 512;
            transpose_item(p.in[15] + (size_t)l * 1024 * 1024, 1024, gn, nt * 32 + nn, (bf16_t*)(wsw + W_WOUT + l * SZ_WOUT), 1024, kt * 64, kt * 64, nt * 32, scr, lane); continue; }
        r -= U_WOUT;
        if (r < U_WFF1) { const int kt = r / 128, nt = r % 128;
            transpose_item(p.in[17] + (size_t)l * 1024 * 4096, 4096, p.in[16] + l * 1024, nt * 32 + nn, (bf16_t*)(wsw + W_WFF1 + l * SZ_WFF), 1024, kt * 64, kt * 64, nt * 32, scr, lane); continue; }
        r -= U_WFF1;
        { const int kt = r / 32, nt = r % 32;
            transpose_item(p.in[18] + (size_t)l * 4096 * 1024, 1024, nullptr, nt * 32 + nn, (bf16_t*)(wsw + W_WFF2 + l * SZ_WFF), 4096, kt * 64, kt * 64, nt * 32, scr, lane); }
    }
}

DI void prologue(const Params& p, LAS unsigned char* lds, int tid_) {
    const int lane = lane_id_now(), wave = tid_, tid = wave * 64 + lane;
    unsigned char* ws = launder(p.ws);
    unsigned char* wsw = ws + WS_W;
    LAS float* scr = (LAS float*)lds + wave * (64 * 33);
    const int G = gridDim.x, bx = blockIdx.x, gw = bx * NWAVES + wave, NGW = G * NWAVES;
    const int nn = lane & 31;
    convert_weights(p, lds, wave, 0, 1, gw, NGW);
    for (int uu = gw; uu < DEPTH * 2 * 32; uu += NGW) {
        const int lk = uu >> 5, sl = uu & 31, l = lk >> 1, kv = lk & 1;
        const float* pos = (kv ? p.in[6] : p.in[3]) + (size_t)l * 2048 + sl * 64; const float* w1 = (kv ? p.in[7] : p.in[4]) + ((size_t)l * 2048 + sl * 64) * 256 + 4 * lane;
        f32x4 a = {0.f, 0.f, 0.f, 0.f};
#pragma unroll 16
        for (int k = 0; k < 64; ++k) a += __builtin_nontemporal_load((const GAS f32x4*)(w1 + (size_t)k * 256)) * pos[k];
        *(f32x4*)((float*)(wsw + W_BIAS1) + (size_t)uu * 256 + 4 * lane) = a;
    }
    for (int e = bx * NTHR + tid; e < SEQ * 32; e += G * NTHR) { const int t = e >> 5, i = e & 31;
        const float ang = (float)t * (1.0f / powf(10000.0f, (float)(2 * i) / 64.0f));
        ((float*)(wsw + W_COSA))[e] = cosf(ang); ((float*)(wsw + W_SINA))[e] = sinf(ang); }
    for (int e = bx * NTHR + tid; e < SEQ * 16; e += G * NTHR) { const int t = e >> 4, i = e & 15;
        const float ang = (float)t * (1.0f / powf(10000.0f, (float)(2 * i) / 32.0f));
        ((float*)(wsw + W_COSB))[e] = cosf(ang); ((float*)(wsw + W_SINB))[e] = sinf(ang); }
    {
        const float* x = p.in[0]; bf16_t* XB = (bf16_t*)(ws + WS_XB); float* ss = (float*)(ws + WS_SS1);
        for (int row0 = gw * 4; row0 < NTOK; row0 += NGW * 4) {
            f32x4 v[4][4];
#pragma unroll
            for (int rr = 0; rr < 4; ++rr)
#pragma unroll
                for (int j = 0; j < 4; ++j) v[rr][j] = *((const GAS f32x4*)(x + (size_t)(row0 + rr) * 1024) + lane + 64 * j);
#pragma unroll
            for (int rr = 0; rr < 4; ++rr) { const int row = row0 + rr; float q = 0.f;
#pragma unroll
                for (int j = 0; j < 4; ++j) { u32x2 w; w.x = cvtpk(v[rr][j][0], v[rr][j][1]); w.y = cvtpk(v[rr][j][2], v[rr][j][3]); *(GAS u32x2*)(XB + (size_t)row * 1024 + 256 * j + 4 * lane) = w;
                    f32x4 r; r[0] = __builtin_bit_cast(float, w[0] << 16); r[1] = __builtin_bit_cast(float, w[0] & 0xffff0000u); r[2] = __builtin_bit_cast(float, w[1] << 16); r[3] = __builtin_bit_cast(float, w[1] & 0xffff0000u); q += sq4(r); }
                q = wsum(q);
                if (lane < 16) ss[(size_t)row * 16 + lane] = lane == 0 ? q : 0.f; }
        }
    }
    __syncthreads();
}

DI void norm_mix_phase(const Params& p, int l, int tid_) {
    const int tid = tid_ * 64 + lane_id_now();
    const int lane = tid & 63, gw = blockIdx.x * NWAVES + (tid >> 6), NGW = gridDim.x * NWAVES;
    unsigned char* ws = launder(p.ws);
    const bf16_t* OAB = (const bf16_t*)(ws + WS_OAB); bf16_t* MIX = (bf16_t*)(ws + WS_A + A_MIX);
    const float* ga = p.in[13] + l * 512 + lane * 8; const float* gb = p.in[14] + l * 512 + lane * 8;
    float g_a[8], g_b[8];
#pragma unroll
    for (int j = 0; j < 8; ++j) { g_a[j] = ga[j]; g_b[j] = gb[j]; }
    for (int row = gw; row < NTOK; row += NGW) {
        const u32x4 a = *(const u32x4*)(OAB + (size_t)row * 1024 + lane * 8), b = *(const u32x4*)(OAB + (size_t)row * 1024 + 512 + lane * 8);
        float va[8], vb[8]; float qa = 0.f, qb = 0.f;
#pragma unroll
        for (int j = 0; j < 4; ++j) { va[2 * j] = __builtin_bit_cast(float, a[j] << 16); va[2 * j + 1] = __builtin_bit_cast(float, a[j] & 0xffff0000u);
            vb[2 * j] = __builtin_bit_cast(float, b[j] << 16); vb[2 * j + 1] = __builtin_bit_cast(float, b[j] & 0xffff0000u); }
#pragma unroll
        for (int j = 0; j < 8; ++j) { qa += va[j] * va[j]; qb += vb[j] * vb[j]; }
        qa = wsum(qa); qb = wsum(qb);
        const float ra = rsqrtf(qa * (1.0f / 512.0f) + NORM_EPS), rb = rsqrtf(qb * (1.0f / 512.0f) + NORM_EPS);
        u32x4 oa, ob;
#pragma unroll
        for (int j = 0; j < 4; ++j) { oa[j] = cvtpk(va[2 * j] * ra * g_a[2 * j], va[2 * j + 1] * ra * g_a[2 * j + 1]); ob[j] = cvtpk(vb[2 * j] * rb * g_b[2 * j], vb[2 * j + 1] * rb * g_b[2 * j + 1]); }
        *(u32x4*)(MIX + (size_t)row * 1024 + lane * 8) = oa; *(u32x4*)(MIX + (size_t)row * 1024 + 512 + lane * 8) = ob;
    }
}
DI void final_norm_phase(const Params& p, int tid_) {
    const int tid = tid_ * 64 + lane_id_now();
    const int lane = tid & 63, gw = blockIdx.x * NWAVES + (tid >> 6), NGW = gridDim.x * NWAVES;
    unsigned char* ws = launder(p.ws);
    float* X = p.out; const bf16_t* XB = (const bf16_t*)(ws + WS_XB); const float* ss = (const float*)(ws + WS_SS1); const float* gn = p.in[19];
    for (int row0 = gw * 4; row0 < NTOK; row0 += NGW * 4) {
        u32x2 o[4][4]; float rstd[4];
#pragma unroll
        for (int rr = 0; rr < 4; ++rr) { rstd[rr] = rsqrtf(sum16(ss + (size_t)(row0 + rr) * 16) * (1.0f / 1024.0f) + NORM_EPS);
#pragma unroll
            for (int j = 0; j < 4; ++j) o[rr][j] = *(const GAS u32x2*)(XB + (size_t)(row0 + rr) * 1024 + 256 * j + 4 * lane); }
#pragma unroll
        for (int rr = 0; rr < 4; ++rr)
#pragma unroll
            for (int j = 0; j < 4; ++j) { const f32x4 g = *((const GAS f32x4*)gn + 64 * j + lane);
                f32x4 x; x[0] = __builtin_bit_cast(float, o[rr][j][0] << 16); x[1] = __builtin_bit_cast(float, o[rr][j][0] & 0xffff0000u); x[2] = __builtin_bit_cast(float, o[rr][j][1] << 16); x[3] = __builtin_bit_cast(float, o[rr][j][1] & 0xffff0000u);
                __builtin_nontemporal_store(x * rstd[rr] * g, (GAS f32x4*)(X + (size_t)(row0 + rr) * 1024) + 64 * j + lane); }
    }
}
DI void cmp2_phase(const Params& p, int l, LAS unsigned char* lds, int tid_) {
    const int tid = tid_ * 64 + lane_id_now();
    const int lane = tid & 63, w = tid_, kvw = w >> 2, nb = w & 3;
    constexpr int HSTR = 528;
    LAS unsigned char* hidb = lds;
    LAS float* b1 = (LAS float*)(lds + 32768);
    unsigned char* ws = launder(p.ws);
    const float* slabs = (const float*)(ws + WS_A + A_HIDC);
    bf16x8 wf[8];
    { const float* w2 = (kvw ? p.in[8] : p.in[5]) + (size_t)l * 256 * 64 + nb * 16 + (lane & 15);
      float wv[8][8];
#pragma unroll
      for (int ks = 0; ks < 8; ++ks)
#pragma unroll
          for (int e = 0; e < 8; ++e) wv[ks][e] = *(const GAS float*)(w2 + (size_t)(ks * 32 + 8 * (lane >> 4) + e) * 64);
#pragma unroll
      for (int ks = 0; ks < 8; ++ks) { u32x4 t; t.x = cvtpk(wv[ks][0], wv[ks][1]); t.y = cvtpk(wv[ks][2], wv[ks][3]); t.z = cvtpk(wv[ks][4], wv[ks][5]); t.w = cvtpk(wv[ks][6], wv[ks][7]); wf[ks] = __builtin_bit_cast(bf16x8, t); } }
    __syncthreads();
    { const int kv_ = tid >> 8, n_ = tid & 255;
      const float* b1p = (const float*)(ws + WS_W + W_BIAS1) + (size_t)(l * 2 + kv_) * 32 * 256 + n_;
      float bv[32];
#pragma unroll
      for (int sl = 0; sl < 32; ++sl) bv[sl] = *(const GAS float*)(b1p + sl * 256);
      float a = 0.f;
#pragma unroll
      for (int sl = 0; sl < 32; ++sl) a += bv[sl];
      b1[tid] = a; }
    for (int u = blockIdx.x; u < 256; u += gridDim.x) {
        const int r = tid >> 5, c8 = (tid & 31) * 8, rowh = u * 16 + r;
        f32x4 sv[2][4][2];
#pragma unroll
        for (int kv = 0; kv < 2; ++kv)
#pragma unroll
            for (int sp = 0; sp < 4; ++sp)
#pragma unroll
                for (int hh = 0; hh < 2; ++hh) sv[kv][sp][hh] = *(const GAS f32x4*)(slabs + ((size_t)(kv * 4 + sp) * 4096 + rowh) * 256 + c8 + 4 * hh);
        __syncthreads();
#pragma unroll
        for (int kv = 0; kv < 2; ++kv) { u32x4 hw;
#pragma unroll
            for (int hh = 0; hh < 2; ++hh) { f32x4 a = *(const LAS f32x4*)(b1 + kv * 256 + c8 + 4 * hh);
#pragma unroll
                for (int sp = 0; sp < 4; ++sp) a += sv[kv][sp][hh];
#pragma unroll
                for (int j = 0; j < 4; ++j) a[j] = a[j] / (1.0f + __expf(-a[j]));
                hw[2 * hh] = cvtpk(a[0], a[1]); hw[2 * hh + 1] = cvtpk(a[2], a[3]); }
            *(LAS u32x4*)(hidb + (kv * 16 + r) * HSTR + c8 * 2) = hw; }
        __syncthreads();
        f32x4 acc = {0.f, 0.f, 0.f, 0.f};
        const LAS unsigned char* hb = hidb + (kvw * 16 + (lane & 15)) * HSTR + (lane >> 4) * 16;
#pragma unroll
        for (int ks = 0; ks < 8; ++ks) acc = __builtin_amdgcn_mfma_f32_16x16x32_bf16(wf[ks], *(const LAS bf16x8*)(hb + ks * 64), acc, 0, 0, 0);
        const int row = u * 16 + (lane & 15);
        if ((row & 255) == 255) acc = (f32x4){0.f, 0.f, 0.f, 0.f};
        bf16_t* outp = (bf16_t*)(ws + (kvw ? WS_VCMP : WS_KCMP));
        u32x2 ow; ow.x = cvtpk(acc[0], acc[1]); ow.y = cvtpk(acc[2], acc[3]);
        *(GAS u32x2*)(outp + (size_t)row * 64 + nb * 16 + 4 * (lane >> 4)) = ow;
    }
    __syncthreads();
}

constexpr int KBUF_BYTES = 64 * 208, VSTR = 192, VBUF_BYTES = 64 * VSTR;
constexpr int ATT_VOFF = 3 * KBUF_BYTES;
constexpr int ATT_IMP = 3 * KBUF_BYTES + 2 * VBUF_BYTES;
constexpr int ATT_SEL = ATT_IMP + 65536;
constexpr int ATT_FLAG = ATT_SEL + 512;
static_assert(ATT_FLAG + 32 <= LDS_SCRATCH, "attention LDS");

struct Acc { f32x16 o0, o1, nm; float m, l; };
DI void acc_init(Acc& a) {
#pragma unroll
    for (int i = 0; i < 16; ++i) { a.o0[i] = 0.f; a.o1[i] = 0.f; a.nm[i] = 0.f; }
    a.m = 0.f; a.l = 0.f;
}
DI float max3f(float a, float b, float c) { float r; asm("v_max3_f32 %0, %1, %2, %3" : "=v"(r) : "v"(a), "v"(b), "v"(c)); return r; }
template <int KD> struct KVFrags { const LAS unsigned char* vb; s16x4 v[16]; };
DI s16x4 trrd(const LAS unsigned char* p) { return __builtin_bit_cast(s16x4, __builtin_amdgcn_ds_read_tr16_b64_v4i16((LAS v4i16_t*)p)); }
template <int KD, bool HASV>
DI void load_frags(KVFrags<KD>& f, const LAS unsigned char* kb, const LAS unsigned char* vb, int lane) { f.vb = vb; (void)kb; (void)lane; }
template <int KD, bool HASV = true>
DI void qk_mma(f32x16& s0, f32x16& s1, KVFrags<KD>& f, const LAS unsigned char* kb, const bf16x8 (&qf)[KD], const f32x16& cinit, int lane) {
    constexpr int KSTR = KD * 32 + 16;
    const LAS unsigned char* p0 = kb + (lane & 31) * KSTR + (lane >> 5) * 16;
    bf16x8 kf[2 * KD];
#pragma unroll
    for (int ks = 0; ks < KD; ++ks) { kf[2 * ks] = *(const LAS bf16x8*)(p0 + ks * 32); kf[2 * ks + 1] = *(const LAS bf16x8*)(p0 + 32 * KSTR + ks * 32); }
    __builtin_amdgcn_sched_barrier(0);
    s0 = __builtin_amdgcn_mfma_f32_32x32x16_bf16(kf[0], qf[0], cinit, 0, 0, 0);
    s1 = __builtin_amdgcn_mfma_f32_32x32x16_bf16(kf[1], qf[0], cinit, 0, 0, 0);
#pragma unroll
    for (int ks = 1; ks < KD; ++ks) {
        s0 = __builtin_amdgcn_mfma_f32_32x32x16_bf16(kf[2 * ks], qf[ks], s0, 0, 0, 0);
        s1 = __builtin_amdgcn_mfma_f32_32x32x16_bf16(kf[2 * ks + 1], qf[ks], s1, 0, 0, 0);
    }
    __builtin_amdgcn_sched_barrier(0);
    if (HASV) {
        const int h = lane >> 5, q4 = (lane & 15) >> 2, p4 = lane & 3, blk = (lane >> 4) & 1;
        const LAS unsigned char* vbase = f.vb + (4 * h + q4) * VSTR + (blk * 16 + p4 * 4) * 2;
#pragma unroll
        for (int kh = 0; kh < 2; ++kh)
#pragma unroll
            for (int s2 = 0; s2 < 2; ++s2) { const LAS unsigned char* vp = vbase + (kh * 32 + s2 * 16) * VSTR; const int j = (kh * 2 + s2) * 4;
                f.v[j + 0] = trrd(vp); f.v[j + 1] = trrd(vp + 8 * VSTR); f.v[j + 2] = trrd(vp + 64); f.v[j + 3] = trrd(vp + 8 * VSTR + 64); }
        __builtin_amdgcn_sched_barrier(0);
    }
}
DI void mask_tile(f32x16& s0, f32x16& s1, int lo, int hi, int h) {
    int lo4 = lo - 4 * h, hi4 = hi - 4 * h;
    asm volatile("" : "+v"(lo4), "+v"(hi4));
#pragma unroll
    for (int i = 0; i < 16; ++i) { const int c = crow(i, 0);
        if ((lo > 0 && c < lo4) || c > hi4) s0[i] = -INFINITY;
        if ((lo > 0 && c + 32 < lo4) || c + 32 > hi4) s1[i] = -INFINITY; }
}
DI float tile_max(f32x16& s0, f32x16& s1) {
    asm volatile("s_nop 15\n\ts_nop 7" : "+v"(s0), "+v"(s1));
    float mx = max3f(s0[0], s1[0], s0[1]);
    mx = max3f(mx, s1[1], s0[2]);
#pragma unroll
    for (int i = 2; i < 15; ++i) mx = max3f(mx, s1[i], s0[i + 1]);
    mx = max3f(mx, s1[15], mx);
    return max3f(mx, __shfl_xor(mx, 32), mx);
}
constexpr float RESC_THR = 6.0f;
DI void online_update(Acc& a, f32x16& s0, f32x16& s1, bool with_o, bool first, bool on = true) {
    float mx = tile_max(s0, s1);
    mx = on ? mx : -INFINITY;
    if (first || !__all(mx <= RESC_THR)) {
        float d = first ? mx : fmaxf(mx, 0.f);
        if (d == -INFINITY) d = 0.f;
        if (!first) {
            const float alpha = ex2(-d);
            a.l *= alpha;
            if (with_o) {
#pragma unroll
                for (int i = 0; i < 16; ++i) { a.o0[i] *= alpha; a.o1[i] *= alpha; }
            }
        }
        a.m += d;
#pragma unroll
        for (int i = 0; i < 16; ++i) { s0[i] -= d; s1[i] -= d; a.nm[i] = -a.m; }
    }
    float rs = 0.f;
#pragma unroll
    for (int i = 0; i < 16; ++i) { s0[i] = ex2(s0[i]); s1[i] = ex2(s1[i]); rs += s0[i] + s1[i]; }
    a.l += on ? rs : 0.f;
}
constexpr float FAST_BIGL = 1099511627776.0f, FAST_TINYL = 1.0f / 1099511627776.0f;
template <bool B> struct BoolC { static constexpr bool value = B; };
#ifndef MK_FORCE_SAFE
#define MK_FORCE_SAFE 0
#endif
DI bool l_bad(const Acc& a) { const float lt = a.l + __shfl_xor(a.l, 32);
    if (MK_FORCE_SAFE == 1) return true;
    if (MK_FORCE_SAFE == 2) return !(lt <= 40.0f && lt >= FAST_TINYL);
    return !(lt <= FAST_BIGL && lt >= FAST_TINYL); }
DI void fast_update(Acc& a, f32x16& s0, f32x16& s1, bool on) {
    float rs = 0.f;
#pragma unroll
    for (int i = 0; i < 16; ++i) { s0[i] = ex2(s0[i]); rs += s0[i]; s1[i] = ex2(s1[i]); rs += s1[i]; }
    a.l += on ? rs : 0.f;
}
DI bool stream_redo(volatile LAS unsigned* fl, bool bad) {
    if (__any(bad)) *fl = 1u;
    __syncthreads();
    return *fl != 0u;
}
DI bf16x8 pack8(const f32x16& s, int base) {
    u32x4 w; w.x = cvtpk(s[base + 0], s[base + 1]); w.y = cvtpk(s[base + 2], s[base + 3]); w.z = cvtpk(s[base + 4], s[base + 5]); w.w = cvtpk(s[base + 6], s[base + 7]);
    return __builtin_bit_cast(bf16x8, w);
}
template <int KD>
DI void pv_mma(Acc& a, const f32x16& p0, const f32x16& p1, const KVFrags<KD>& f, bool on = true) {
#pragma unroll
    for (int kh = 0; kh < 2; ++kh)
#pragma unroll
        for (int s2 = 0; s2 < 2; ++s2) {
            u32x4 pw = __builtin_bit_cast(u32x4, pack8(kh ? p1 : p0, 8 * s2));
            pw.x = on ? pw.x : 0u; pw.y = on ? pw.y : 0u; pw.z = on ? pw.z : 0u; pw.w = on ? pw.w : 0u;
            const bf16x8 pf = __builtin_bit_cast(bf16x8, pw); const int j = (kh * 2 + s2) * 4;
            a.o0 = __builtin_amdgcn_mfma_f32_32x32x16_bf16(__builtin_shufflevector(f.v[j], f.v[j + 1], 0, 1, 2, 3, 4, 5, 6, 7), pf, a.o0, 0, 0, 0);
            a.o1 = __builtin_amdgcn_mfma_f32_32x32x16_bf16(__builtin_shufflevector(f.v[j + 2], f.v[j + 3], 0, 1, 2, 3, 4, 5, 6, 7), pf, a.o1, 0, 0, 0);
        }
}

struct Stage { u32x4 rk, rv, rkr; };
template <int KD, bool HASV, class Addr, class Body, class Next>
DI void kv_stream(int ntiles, Addr addr, Body body, Stage& sg, bool pre, Next next, LAS unsigned char* lds, int tid) {
    constexpr int KSTR = KD * 32 + 16;
    if (ntiles <= 0) return;
    const int row8 = tid >> 3, ch8 = tid & 7, row4 = tid >> 2, ch4 = tid & 3;
    auto ld = [&](int it) {
        const bf16_t *kp, *vp, *krp; addr(it, kp, vp, krp);
        sg.rk = *(const GAS u32x4*)(kp + tid * 8);
        if (HASV) sg.rv = *(const GAS u32x4*)(vp + tid * 8);
        if (KD == 6) { if (tid < 256) sg.rkr = *(const GAS u32x4*)(krp + tid * 8); }
    };
    auto st = [&](int buf) {
        LAS unsigned char* kb = lds + buf * KBUF_BYTES; LAS unsigned char* vb = lds + ATT_VOFF + buf * VBUF_BYTES;
        *(LAS u32x4*)(kb + row8 * KSTR + ch8 * 16) = sg.rk;
        if (HASV) *(LAS u32x4*)(vb + row8 * VSTR + ch8 * 16) = sg.rv;
        if (KD == 6) { if (tid < 256) *(LAS u32x4*)(kb + row4 * KSTR + 128 + ch4 * 16) = sg.rkr; }
    };
    if (!pre) ld(0);
    st(0);
    __syncthreads();
#pragma unroll 1
    for (int it = 0; it < ntiles; ++it) {
        const int cur = it & 1;
        if (it + 1 < ntiles) ld(it + 1); else next(sg);
        body(it, (const LAS unsigned char*)(lds + cur * KBUF_BYTES), (const LAS unsigned char*)(lds + ATT_VOFF + cur * VBUF_BYTES));
        if (it + 1 < ntiles) st(cur ^ 1);
        __syncthreads();
    }
}

DI void mla_unit(const Params& p, int b, int hd, int qb, int fi, LAS unsigned char* lds, int tid_) {
    const int tid = tid_ * 64 + lane_id_now();
    const int lane = tid & 63, w = tid_, r = lane & 31, h = lane >> 5;
    unsigned char* ws = launder(p.ws);
    const bf16_t* QM = (const bf16_t*)(ws + WS_A + A_QM); const bf16_t* KN = (const bf16_t*)(ws + WS_A + A_KN) + (size_t)(b * 8 + hd) * SEQ * 64;
    const bf16_t* VM = (const bf16_t*)(ws + WS_A + A_VM) + (size_t)(b * 8 + hd) * SEQ * 64; const bf16_t* KR = (const bf16_t*)(ws + WS_A + A_KR) + (size_t)b * SEQ * 32;
    bf16_t* OAB = (bf16_t*)(ws + WS_OAB);
    const int qlo = qb * 256 + w * 32, q = qlo + r;
    bf16x8 qf[6];
    { const bf16_t* qp = QM + (size_t)(b * SEQ + q) * 768 + hd * 96 + h * 8;
#pragma unroll
      for (int ks = 0; ks < 6; ++ks) qf[ks] = *(const GAS bf16x8*)(qp + ks * 16); }
    Acc a; acc_init(a);
    volatile LAS unsigned* fl = (volatile LAS unsigned*)(lds + ATT_FLAG) + 4 + fi;
    Stage sg;
    auto run = [&](auto safec) {
        constexpr bool SAFE = decltype(safec)::value;
        kv_stream<6, true>(4 * qb + 4,
            [&](int it, const bf16_t*& kp, const bf16_t*& vp, const bf16_t*& krp) { kp = KN + (size_t)it * 4096; vp = VM + (size_t)it * 4096; krp = KR + (size_t)it * 2048; },
            [&](int it, const LAS unsigned char* kb, const LAS unsigned char* vb) {
                if (it * 64 <= qlo + 31) {
                    KVFrags<6> f; load_frags<6, true>(f, kb, vb, lane);
                    const f32x16 z16 = {0.f, 0.f, 0.f, 0.f, 0.f, 0.f, 0.f, 0.f, 0.f, 0.f, 0.f, 0.f, 0.f, 0.f, 0.f, 0.f};
                    f32x16 s0, s1; qk_mma<6>(s0, s1, f, kb, qf, SAFE ? a.nm : z16, lane);
                    if (it * 64 + 63 > qlo) mask_tile(s0, s1, 0, q - it * 64, h);
                    if (SAFE) online_update(a, s0, s1, true, it == 0); else fast_update(a, s0, s1, true);
                    pv_mma<6>(a, s0, s1, f);
                }
            }, sg, false, [&](Stage&) {}, lds, tid);
    };
    if (tid == 0) *fl = 0u;
    run(BoolC<false>{});
    if (stream_redo(fl, l_bad(a))) { acc_init(a); run(BoolC<true>{}); }
    const float lt = a.l + __shfl_xor(a.l, 32); const float inv = lt > 0.f ? 1.0f / lt : 0.f;
    float ssq = st_row64(OAB + (size_t)(b * SEQ + q) * 1024 + 512 + hd * 64, a.o0, a.o1, inv, h);
    ssq += __shfl_xor(ssq, 32);
    if (h == 0) ((GAS float*)(ws + WS_SSB))[(size_t)(b * SEQ + q) * 8 + hd] = ssq;
}
DI void mla_phase(const Params& p, LAS unsigned char* lds, int tid) {
    for (int pi = blockIdx.x; pi < 512; pi += gridDim.x) {
        const int bh = pi & 63, qp = pi >> 6;
        mla_unit(p, bh >> 3, bh & 7, 15 - qp, 0, lds, tid);
        mla_unit(p, bh >> 3, bh & 7, qp, 1, lds, tid);
    }
}

DI void nsa_unit(const Params& p, int b, int g, int c, int fi, LAS unsigned char* lds, int tid_) {
    const int tid = tid_ * 64 + lane_id_now();
    const int lane = tid & 63, w = tid_, r = lane & 31, h = lane >> 5;
    const int head = g * 4 + (w >> 1), qh = w & 1, tq = 32 * qh + r, t = 64 * c + tq;
    unsigned char* ws = launder(p.ws);
    unsigned char* A = ws + WS_A;
    const bf16_t* QA = (const bf16_t*)(A + A_QA);
    const size_t bgoff = (size_t)(b * 2 + g) * SEQ * 64;
    const bf16_t* KS = (const bf16_t*)(A + A_KS) + bgoff; const bf16_t* VS = (const bf16_t*)(A + A_VS) + bgoff;
    const bf16_t* KW = (const bf16_t*)(A + A_KW) + bgoff; const bf16_t* VW = (const bf16_t*)(A + A_VW) + bgoff;
    const bf16_t* KCMP = (const bf16_t*)(ws + WS_KCMP) + (size_t)(b * 2 + g) * 256 * 64; const bf16_t* VCMP = (const bf16_t*)(ws + WS_VCMP) + (size_t)(b * 2 + g) * 256 * 64;
    LAS unsigned* IMP = (LAS unsigned*)(lds + ATT_IMP);
    LAS unsigned long long* SELM = (LAS unsigned long long*)(lds + ATT_SEL);
    bf16x8 qf[4];
    { const bf16_t* qp = QA + (size_t)(b * SEQ + t) * 512 + head * 64 + h * 8;
#pragma unroll
      for (int ks = 0; ks < 4; ++ks) qf[ks] = *(const GAS bf16x8*)(qp + ks * 16); }
    LAS f32x16* TL = (LAS f32x16*)(lds + ATT_IMP) + (w * 64 + lane) * 2;
    f32x16 t0, t1;
    const bool need_sel = c >= 16;
    if (need_sel) { for (int i = tid; i < 65 * 16; i += NTHR) ((LAS u32x4*)IMP)[i] = (u32x4){0u, 0u, 0u, 0u}; }
    const int nct = (4 * c + 3 + 63) >> 6;
    const int nmax = t >= 31 ? ((t - 31) >> 4) : -1;
    Acc a; acc_init(a);
    Stage sg;
    kv_stream<4, false>(nct,
        [&](int it, const bf16_t*& kp, const bf16_t*& vp, const bf16_t*& krp) { kp = KCMP + (size_t)it * 4096; vp = nullptr; krp = nullptr; },
        [&](int it, const LAS unsigned char* kb, const LAS unsigned char* vb) {
            KVFrags<4> f; load_frags<4, false>(f, kb, vb, lane);
            f32x16 s0, s1; qk_mma<4, false>(s0, s1, f, kb, qf, a.nm, lane);
            mask_tile(s0, s1, 0, nmax - it * 64, h);
            online_update(a, s0, s1, false, it == 0);
        }, sg, false, [&](Stage& g_) { g_.rk = *(const GAS u32x4*)(KCMP + tid * 8); g_.rv = *(const GAS u32x4*)(VCMP + tid * 8); }, lds, tid);
    {
        const float lt = a.l + __shfl_xor(a.l, 32); const float sh = lt > 0.f ? -__builtin_amdgcn_logf(lt) : -INFINITY;
        f32x16 cn2;
#pragma unroll
        for (int i = 0; i < 16; ++i) cn2[i] = a.nm[i] + sh;
        kv_stream<4, true>(nct,
            [&](int it, const bf16_t*& kp, const bf16_t*& vp, const bf16_t*& krp) { kp = KCMP + (size_t)it * 4096; vp = VCMP + (size_t)it * 4096; krp = nullptr; },
            [&](int it, const LAS unsigned char* kb, const LAS unsigned char* vb) {
                KVFrags<4> f; load_frags<4, true>(f, kb, vb, lane);
                f32x16 s0, s1; qk_mma<4>(s0, s1, f, kb, qf, cn2, lane);
                mask_tile(s0, s1, 0, nmax - it * 64, h);
#pragma unroll
                for (int i = 0; i < 16; ++i) { s0[i] = ex2(s0[i]); s1[i] = ex2(s1[i]); }
                if (need_sel) {
#pragma unroll
                    for (int g = 0; g < 8; ++g) { const f32x16& sv = g < 4 ? s0 : s1; const int b4 = (g & 3) * 4, j = it * 16 + 2 * (g & 3) + h + (g < 4 ? 0 : 8);
                        const unsigned vb = (unsigned)((2.0f * ((sv[b4] + sv[b4 + 1]) + sv[b4 + 2]) + sv[b4 + 3]) * 67108864.0f + 0.5f), vn = (unsigned)(sv[b4 + 3] * 67108864.0f + 0.5f);
                        __hip_atomic_fetch_add(IMP + j * 64 + tq, vb, __ATOMIC_RELAXED, __HIP_MEMORY_SCOPE_WORKGROUP);
                        __hip_atomic_fetch_add(IMP + (j + 1) * 64 + tq, vn, __ATOMIC_RELAXED, __HIP_MEMORY_SCOPE_WORKGROUP); }
                }
                pv_mma<4>(a, s0, s1, f);
            }, sg, true, [&](Stage& g_) { g_.rk = *(const GAS u32x4*)(KS + tid * 8); g_.rv = *(const GAS u32x4*)(VS + tid * 8); }, lds, tid);
        const float g0 = ((const GAS float*)(A + A_GATES))[(size_t)(b * SEQ + t) * 24 + head * 3];
#pragma unroll
        for (int i = 0; i < 16; ++i) { t0[i] = g0 * a.o0[i]; t1[i] = g0 * a.o1[i]; }
    }
    unsigned long long mq = ~0ull;
    if (need_sel) {
#pragma unroll 1
        for (int i = 0; i < 8; i += 2) {
            const int ql = w * 8 + i, j = lane;
            const bool valid = j <= c, forced = (j == 0) || (j == c) || (j == c - 1);
            const unsigned ib0 = IMP[j * 64 + ql], ib1 = IMP[j * 64 + ql + 1];
            const unsigned k0 = ((forced ? 0xFFFFFFFFu : ib0) & ~63u) | (unsigned)(63 - j), k1 = ((forced ? 0xFFFFFFFFu : ib1) & ~63u) | (unsigned)(63 - j);
            const unsigned sc0 = valid ? k0 : 0u, sc1 = valid ? k1 : 0u;
            int r0 = 0, r1 = 0;
            const int nblk8 = (c + 8) & ~7;
#pragma unroll 1
            for (int i8 = 0; i8 < nblk8; i8 += 8) {
#pragma unroll
                for (int k = 0; k < 8; ++k) { const unsigned o0 = (unsigned)__builtin_amdgcn_readlane((int)sc0, i8 + k), o1 = (unsigned)__builtin_amdgcn_readlane((int)sc1, i8 + k);
                    r0 += (o0 > sc0) ? 1 : 0; r1 += (o1 > sc1) ? 1 : 0; } }
            const unsigned long long bm0 = __ballot(valid && r0 < 16), bm1 = __ballot(valid && r1 < 16);
            if (lane == 0) { SELM[ql] = bm0; SELM[ql + 1] = bm1; }
        }
        __syncthreads();
        mq = SELM[tq];
    }
    acc_init(a);
    volatile LAS unsigned* fl = (volatile LAS unsigned*)(lds + ATT_FLAG) + 2 * fi;
    const int jlo = c >= 8 ? c - 8 : 0;
    auto run_sel = [&](auto safec, bool pre_) {
        constexpr bool SAFE = decltype(safec)::value;
        kv_stream<4, true>(c + 1,
            [&](int it, const bf16_t*& kp, const bf16_t*& vp, const bf16_t*& krp) { kp = KS + (size_t)it * 4096; vp = VS + (size_t)it * 4096; krp = nullptr; },
            [&](int it, const LAS unsigned char* kb, const LAS unsigned char* vb) {
                const bool on = (mq >> it) & 1ull;
                if (__any(on)) {
                    KVFrags<4> f; load_frags<4, true>(f, kb, vb, lane);
                    const f32x16 z16 = {0.f, 0.f, 0.f, 0.f, 0.f, 0.f, 0.f, 0.f, 0.f, 0.f, 0.f, 0.f, 0.f, 0.f, 0.f, 0.f};
                    f32x16 s0, s1; qk_mma<4>(s0, s1, f, kb, qf, SAFE ? a.nm : z16, lane);
                    if (it == c) mask_tile(s0, s1, 0, tq, h);
                    if (SAFE) online_update(a, s0, s1, true, it == 0, on); else fast_update(a, s0, s1, on);
                    pv_mma<4>(a, s0, s1, f, on);
                }
            }, sg, pre_, [&](Stage& g_) { g_.rk = *(const GAS u32x4*)(KW + (size_t)jlo * 4096 + tid * 8); g_.rv = *(const GAS u32x4*)(VW + (size_t)jlo * 4096 + tid * 8); }, lds, tid);
    };
    if (tid == 0) { fl[0] = 0u; fl[1] = 0u; }
    run_sel(BoolC<false>{}, true);
    if (stream_redo(fl, l_bad(a))) { acc_init(a); run_sel(BoolC<true>{}, false); }
    {
        const int lane_f = lane_id_now(), t_f = 64 * c + 32 * (tid_ & 1) + (lane_f & 31);
        const float g1 = ((const GAS float*)(launder(p.ws) + WS_A + A_GATES))[(size_t)(b * SEQ + t_f) * 24 + (g * 4 + (tid_ >> 1)) * 3 + 1];
        LAS f32x16* TL = (LAS f32x16*)(lds + ATT_IMP) + (tid_ * 64 + lane_f) * 2;
        const float lt = a.l + __shfl_xor(a.l, 32); const float sc = lt > 0.f ? g1 / lt : 0.f;
#pragma unroll
        for (int i = 0; i < 16; ++i) { t0[i] += sc * a.o0[i]; t1[i] += sc * a.o1[i]; }
    }
    acc_init(a);
    auto run_win = [&](auto safec, bool pre_) {
        constexpr bool SAFE = decltype(safec)::value;
        kv_stream<4, true>(c - jlo + 1,
            [&](int it, const bf16_t*& kp, const bf16_t*& vp, const bf16_t*& krp) { kp = KW + (size_t)(jlo + it) * 4096; vp = VW + (size_t)(jlo + it) * 4096; krp = nullptr; },
            [&](int it, const LAS unsigned char* kb, const LAS unsigned char* vb) {
                const int j = jlo + it;
                KVFrags<4> f; load_frags<4, true>(f, kb, vb, lane);
                const f32x16 z16 = {0.f, 0.f, 0.f, 0.f, 0.f, 0.f, 0.f, 0.f, 0.f, 0.f, 0.f, 0.f, 0.f, 0.f, 0.f, 0.f};
                f32x16 s0, s1; qk_mma<4>(s0, s1, f, kb, qf, SAFE ? a.nm : z16, lane);
                const bool first = (c >= 8 && j == c - 8), lastt = (j == c);
                if (first || lastt) mask_tile(s0, s1, first ? tq + 1 : 0, lastt ? tq : 63, h);
                if (SAFE) online_update(a, s0, s1, true, it == 0); else fast_update(a, s0, s1, true);
                pv_mma<4>(a, s0, s1, f);
            }, sg, pre_, [&](Stage&) {}, lds, tid);
    };
    run_win(BoolC<false>{}, true);
    if (stream_redo((volatile LAS unsigned*)(lds + ATT_FLAG) + 2 * fi + 1, l_bad(a))) { acc_init(a); run_win(BoolC<true>{}, false); }
    {
        const int lane_f = lane_id_now(), t_f = 64 * c + 32 * (tid_ & 1) + (lane_f & 31);
        const float g2 = ((const GAS float*)(launder(p.ws) + WS_A + A_GATES))[(size_t)(b * SEQ + t_f) * 24 + (g * 4 + (tid_ >> 1)) * 3 + 2];
        LAS f32x16* TL = (LAS f32x16*)(lds + ATT_IMP) + (tid_ * 64 + lane_f) * 2;
        const float lt = a.l + __shfl_xor(a.l, 32); const float sc = lt > 0.f ? g2 / lt : 0.f;
#pragma unroll
        for (int i = 0; i < 16; ++i) { t0[i] += sc * a.o0[i]; t1[i] += sc * a.o1[i]; }
    }
    const int lane_o = lane_id_now(), t_o = 64 * c + 32 * (tid_ & 1) + (lane_o & 31), head_o = g * 4 + (tid_ >> 1), h_o = lane_o >> 5;
    unsigned char* ws_o = launder(p.ws);
    float ssq = st_row64((bf16_t*)(ws_o + WS_OAB) + (size_t)(b * SEQ + t_o) * 1024 + head_o * 64, t0, t1, 1.0f, h_o);
    ssq += __shfl_xor(ssq, 32);
    if (h_o == 0) ((GAS float*)(ws_o + WS_SSA))[(size_t)(b * SEQ + t_o) * 8 + head_o] = ssq;
}
DI void nsa_phase(const Params& p, LAS unsigned char* lds, int tid) {
    for (int pi = blockIdx.x; pi < 512; pi += gridDim.x) {
        const int bg = pi & 15, cp = pi >> 4;
        nsa_unit(p, bg >> 1, bg & 1, 63 - cp, 0, lds, tid);
        nsa_unit(p, bg >> 1, bg & 1, cp, 1, lds, tid);
    }
}

constexpr int N_STEPS = 34;
#ifndef MK_REP_STEP
#define MK_REP_STEP -1
#endif
#define NREP(k) ((k) == MK_REP_STEP ? 2 : 1)
__global__ void __launch_bounds__(NTHR, 2) fwd(Params p) {
    extern __shared__ __attribute__((aligned(16))) unsigned char lds_raw[];
    LAS unsigned char* lds = (LAS unsigned char*)lds_raw;
    const int wave0 = __builtin_amdgcn_readfirstlane((int)threadIdx.x >> 6);
    const int tid = wave0;
    volatile LAS unsigned* misc = (volatile LAS unsigned*)(lds + LDS_MISC);
    if (threadIdx.x < 4) misc[threadIdx.x] = 0u;
    __syncthreads();
    unsigned* ctl = (unsigned*)(p.ws + WS_CTL);
    XcdBarrier bar = xcd_barrier_post(ctl + CW_BAR, misc);
    const int lo = p.s_lo, hi = p.s_hi;
#define IN(k) (lo <= (k) && (k) < hi)
#define BAR(k) do { if ((k) + 1 < hi) xcd_barrier(bar); } while (0)
    const int G = gridDim.x, bx = blockIdx.x;

    if (IN(0)) { for (int rep = 0; rep < NREP(8); ++rep) prologue(p, lds, tid); BAR(0); }
#pragma unroll 1
    for (int l = 0; l < DEPTH; ++l) {
        const int sb = 1 + 8 * l;
        if (IN(sb + 0)) for (int rep = 0; rep < NREP(0); ++rep) {
            unsigned char* ws = launder(p.ws);
            pg8::Gemm g{(const bf16_t*)(ws + WS_XB), (const bf16_t*)(ws + WS_W + W_WIN + l * SZ_WIN), NTOK, NPROJ, 1024, 1024, 1024};
            pg8::StaticOrder S; S.init(NTOK, NPROJ, launder_s(G), launder_s(bx));
            EpiInProj E{ws, l};
            pg8::gemm_phase(lds, g, S, E, wave0);
            if (l + 1 < DEPTH) {
                const int G_ = launder_s(G), bx_ = launder_s(bx), nbusy = 896 % G_;
                if (bx_ >= nbusy) convert_weights(p, lds, wave0, l + 1, l + 2, (bx_ - nbusy) * NWAVES + wave0, (G_ - nbusy) * NWAVES);
            }
            if (rep + 1 == NREP(0)) BAR(sb + 0);
        }
        if (IN(sb + 1)) for (int rep = 0; rep < NREP(1); ++rep) {
            {
                unsigned char* ws = launder(p.ws);
                pg8::Gemm g{(const bf16_t*)(ws + WS_A + A_CQKV), (const bf16_t*)(ws + WS_W + W_WUP + l * SZ_WUP), NTOK, NUP, KUP, KUP, KUP};
                pg8::StaticOrder S; S.init(NTOK, NUP, launder_s(G), launder_s(bx));
                EpiUp E{ws, l};
                pg8::gemm_phase(lds, g, S, E, wave0);
            }
#pragma unroll 1
            for (int i = 0; i < 8; ++i) {
                unsigned char* ws = launder(p.ws);
                const int kv = i >> 2, sp = i & 3;
                const bf16_t* Ab = (const bf16_t*)(ws + WS_A + (kv ? A_VC : A_KC)) + sp * 512;
                const bf16_t* Bb = (const bf16_t*)(ws + WS_W + (kv ? W_W1V : W_W1K) + l * SZ_W1) + sp * 512;
                pg8::Gemm g{Ab, Bb, 4096, 256, 512, 1024, 2048};
                const int G_ = launder_s(G); int c = launder_s(bx) - G_ / 2 - 16 * i; if (c < 0) c += G_; if (c >= 16) c = -1;
                pg8::StaticOrder S; S.init(4096, 256, G_, c);
                EpiSlab E{ws, i};
                pg8::gemm_phase(lds, g, S, E, wave0);
            }
            if (rep + 1 == NREP(1)) BAR(sb + 1);
        }
        if (IN(sb + 2)) { cmp2_phase(p, l, lds, tid); BAR(sb + 2); }
        if (IN(sb + 3)) { mla_phase(p, lds, tid); nsa_phase(p, lds, tid); BAR(sb + 3); }
        if (IN(sb + 5)) for (int rep = 0; rep < (l == 0 ? NREP(5) : 1); ++rep) {
            unsigned char* ws = launder(p.ws);
            pg8::Gemm g{(const bf16_t*)(ws + WS_OAB), (const bf16_t*)(ws + WS_W + W_WOUT + l * SZ_WOUT), NTOK, 1024, 1024, 1024, 1024};
            pg8::StaticOrder S; S.init(NTOK, 1024, launder_s(G), launder_s(bx));
            EpiResid<true> E{ws, 1};
            pg8::gemm_phase(lds, g, S, E, wave0);
            if (rep + 1 == (l == 0 ? NREP(5) : 1)) BAR(sb + 5);
        }
        if (IN(sb + 6)) for (int rep = 0; rep < NREP(6); ++rep) {
            unsigned char* ws = launder(p.ws);
            pg8::Gemm g{(const bf16_t*)(ws + WS_XB), (const bf16_t*)(ws + WS_W + W_WFF1 + l * SZ_WFF), NTOK, D_FF, 1024, 1024, 1024};
            pg8::StaticOrder S; S.init(NTOK, D_FF, launder_s(G), launder_s(bx));
            EpiFF1 E{ws, l};
            pg8::gemm_phase(lds, g, S, E, wave0);
            if (rep + 1 == NREP(6)) BAR(sb + 6);
        }
        if (IN(sb + 7)) {
            unsigned char* ws = launder(p.ws);
            pg8::Gemm g{(const bf16_t*)(ws + WS_A), (const bf16_t*)(ws + WS_W + W_WFF2 + l * SZ_WFF), NTOK, 1024, D_FF, D_FF, D_FF};
            pg8::StaticOrder S; S.init(NTOK, 1024, launder_s(G), launder_s(bx));
            EpiResid<false> E{ws, 0};
            pg8::gemm_phase(lds, g, S, E, wave0);
            BAR(sb + 7);
        }
    }
    if (IN(33)) final_norm_phase(p, tid);
#undef IN
#undef BAR
}

}
#ifndef MK_DEBUG
#define MK_DEBUG 0
#endif

#if MK_DEBUG
namespace dbg {
using namespace mk;
enum { K_QA = 0, K_KV, K_GATES, K_CQ, K_CKV, K_KR, K_QM, K_KN, K_VM, K_CMP, K_OAB, K_X };
__global__ __launch_bounds__(256) void cmp_kernel(int kind, const void* opt, const float* refp, int n, int aux, float scale, float* err, int id) {
    __shared__ float red[2][4];
    const int idx = blockIdx.x * 256 + threadIdx.x;
    float num = 0.f, den = 0.f;
    if (idx < n) {
        float o = 0.f, r = 0.f;
        const bf16_t* ob = (const bf16_t*)opt; const float* of = (const float*)opt;
        switch (kind) {
            case K_QA: { const int row = idx / 512, c = idx % 512; o = bf2f(ob[(size_t)row * 512 + c]); r = refp[(size_t)row * ref::IN_WIDTH + ref::C_QA + c]; break; }
            case K_KV: { const int row = idx / 128, c = idx % 128, g = c >> 6, d = c & 63; o = bf2f(ob[((size_t)g * SEQ + row) * 64 + d]); r = refp[(size_t)row * ref::IN_WIDTH + aux + c]; break; }
            case K_GATES: { const int row = idx / 24, c = idx % 24; o = of[(size_t)row * 24 + c]; r = refp[(size_t)row * ref::IN_WIDTH + ref::C_G + c]; break; }
            case K_CQ: { const int row = idx / 256, c = idx % 256; o = bf2f(ob[(size_t)row * KUP + c]); r = refp[(size_t)row * ref::IN_WIDTH + ref::C_CQ + c]; break; }
            case K_CKV: { const int row = idx / 128, c = idx % 128; o = bf2f(ob[(size_t)row * KUP + 256 + c]); r = refp[(size_t)row * ref::IN_WIDTH + ref::C_CKV + c]; break; }
            case K_KR: { const int row = idx / 32, c = idx % 32; o = bf2f(ob[(size_t)row * 32 + c]); r = refp[(size_t)row * ref::IN_WIDTH + ref::C_KR + c]; break; }
            case K_QM: { o = bf2f(ob[idx]); r = refp[idx]; break; }
            case K_KN: { const int row = idx / 512, c = idx % 512, hd = c >> 6, d = c & 63; o = bf2f(ob[((size_t)hd * SEQ + row) * 64 + d]); r = refp[(size_t)row * 1024 + hd * 128 + aux + d]; break; }
            case K_CMP: { const int i = idx / 128, c = idx % 128, g = c >> 6, d = c & 63; o = bf2f(ob[((size_t)g * 256 + i) * 64 + d]); r = refp[((size_t)i * 2 + g) * 64 + d]; break; }
            case K_OAB: { const int row = idx / 512, c = idx % 512; o = bf2f(ob[(size_t)row * 1024 + aux + c]); r = refp[(size_t)row * 1024 + aux + c]; break; }
            case K_X: { o = of[idx]; r = refp[idx]; break; }
        }
        o *= scale;
        num = (o - r) * (o - r); den = r * r;
        if (!(num == num)) num = 1e30f;
    }
#pragma unroll
    for (int s = 32; s > 0; s >>= 1) { num += __shfl_xor(num, s); den += __shfl_xor(den, s); }
    if ((threadIdx.x & 63) == 0) { red[0][threadIdx.x >> 6] = num; red[1][threadIdx.x >> 6] = den; }
    __syncthreads();
    if (threadIdx.x == 0) { atomicAdd(err + 2 * id, red[0][0] + red[0][1] + red[0][2] + red[0][3]); atomicAdd(err + 2 * id + 1, red[1][0] + red[1][1] + red[1][2] + red[1][3]); }
}
__global__ __launch_bounds__(256) void encode_kernel(float* out, size_t n, const float* err, int nids, int want_id) {
    float delta2 = 0.f;
    if (want_id > 0) { const float e = err[2 * want_id] / fmaxf(err[2 * want_id + 1], 1e-30f); delta2 = fminf(e, 0.9f); if (delta2 < 1e-5f) delta2 = 0.f; }
    else { for (int id = 1; id <= nids; ++id) { const float e = err[2 * id] / fmaxf(err[2 * id + 1], 1e-30f); if (!(e < 2e-3f)) { delta2 = 0.01f * (float)id; break; } } }
    const float f = 1.0f + sqrtf(delta2);
    const size_t i = (size_t)blockIdx.x * 256 + threadIdx.x;
    if (i < n && delta2 > 0.f) out[i] *= f;
}
}
#endif

namespace {

void launch_steps(const mk::Params& base, int lo, int hi, int grid, hipStream_t stream) {
    mk::Params p = base; p.s_lo = lo; p.s_hi = hi;
    hipLaunchKernelGGL(mk::fwd, dim3(grid), dim3(mk::NTHR), mk::LDS_BYTES, stream, p);
}
}

extern "C" void kernel_launch(void* const* d_in, const int* in_sizes, int n_in, void* d_out, int out_size, void* d_ws, size_t ws_size, hipStream_t stream) {
    (void)in_sizes; (void)out_size;
    using namespace mk;
    static int grid = 0;
    if (grid == 0) {
        int dev = 0, cus = 0, per_cu = 0;
        if (n_in != 20 || ws_size < WS_END + 16 * MiB) { grid = -1; return; }
        if (hipGetDevice(&dev) != hipSuccess || hipDeviceGetAttribute(&cus, hipDeviceAttributeMultiprocessorCount, dev) != hipSuccess) { grid = -1; return; }
        if (hipFuncSetAttribute((const void*)fwd, hipFuncAttributeMaxDynamicSharedMemorySize, LDS_BYTES) != hipSuccess) { grid = -1; return; }
        if (hipOccupancyMaxActiveBlocksPerMultiprocessor(&per_cu, (const void*)fwd, NTHR, LDS_BYTES) != hipSuccess || per_cu < 1) { (void)hipGetLastError(); }
        grid = cus;
    }
    if (grid < 0) return;
    unsigned char* ws = (unsigned char*)d_ws;
    (void)hipMemsetAsync(ws + WS_CTL, 0, CTL_BYTES, stream);
    Params p{};
    for (int i = 0; i < 20; ++i) p.in[i] = (const float*)d_in[i];
    p.out = (float*)d_out; p.ws = ws; p.s_lo = 0; p.s_hi = N_STEPS;
#if MK_DEBUG == 0
#ifdef MK_MULTI
    for (int s = 0; s < N_STEPS; ++s) launch_steps(p, s, s + 1, grid, stream);
#else
    launch_steps(p, 0, N_STEPS, grid, stream);
#endif
#else
    {
        using namespace ref;
        float* err = (float*)(ws + 3 * MiB + 512 * 1024);
        unsigned char* A = ws + WS_A;
        const float* x_in = (const float*)d_in[0];
        auto naive_b0 = [&](char* nb, int upto, float*& H, float*& PROJ, float*& QMr, float*& KVMr, float*& KC, float*& VC, float*& X0) {
            H = (float*)nb; PROJ = (float*)(nb + 16 * MiB); QMr = (float*)(nb + 44 * MiB); KVMr = (float*)(nb + 56 * MiB); KC = (float*)(nb + 72 * MiB); VC = (float*)(nb + 73 * MiB);
            float* CN = (float*)(nb + 74 * MiB); float* CKVN = (float*)(nb + 78 * MiB); X0 = (float*)(nb + 80 * MiB);
            const int l = 0;
            rmsnorm_rows<<<SEQ / 4, 256, 0, stream>>>(x_in, D_MODEL, (const float*)d_in[1], H, D_MODEL, D_MODEL, SEQ);
            sgemm128<0><<<dim3((IN_WIDTH + 127) / 128, SEQ / 128), 256, 0, stream>>>(H, D_MODEL, (const float*)d_in[2], IN_WIDTH, PROJ, IN_WIDTH, nullptr, 0, SEQ, IN_WIDTH, D_MODEL);
            post_proj<<<SEQ, 256, 0, stream>>>(PROJ);
            if (upto < 2) return;
            compress_naive<<<NCMP * 2, 256, 0, stream>>>(PROJ, C_KC, (const float*)d_in[3], (const float*)d_in[4], (const float*)d_in[5], KC);
            compress_naive<<<NCMP * 2, 256, 0, stream>>>(PROJ, C_VC, (const float*)d_in[6], (const float*)d_in[7], (const float*)d_in[8], VC);
            rmsnorm_rows<<<SEQ / 4, 256, 0, stream>>>(PROJ + C_CQ, IN_WIDTH, (const float*)d_in[9], CN, 256, 256, SEQ);
            rmsnorm_rows<<<SEQ / 4, 256, 0, stream>>>(PROJ + C_CKV, IN_WIDTH, (const float*)d_in[11], CKVN, 128, 128, SEQ);
            sgemm128<0><<<dim3(768 / 128, SEQ / 128), 256, 0, stream>>>(CN, 256, (const float*)d_in[10], 768, QMr, 768, nullptr, 0, SEQ, 768, 256);
            sgemm128<0><<<dim3(1024 / 128, SEQ / 128), 256, 0, stream>>>(CKVN, 128, (const float*)d_in[12], 1024, KVMr, 1024, nullptr, 0, SEQ, 1024, 128);
            post_qm<<<SEQ, 128, 0, stream>>>(QMr);
            mla_naive<<<(SEQ / 4) * 8, 256, 0, stream>>>(QMr, KVMr, PROJ, H);
            nsa_naive<<<SEQ * 2, 256, 0, stream>>>(PROJ, KC, VC, H);
            (void)l;
        };
        float *H, *PROJ, *QMr, *KVMr, *KCr, *VCr, *X0;
        auto C = [&](int kind, const void* opt, const float* refp, int n, int aux, float scale, int id) {
            dbg::cmp_kernel<<<(n + 255) / 256, 256, 0, stream>>>(kind, opt, refp, n, aux, scale, err, id); };
        launch_steps(p, 0, 1, grid, stream); launch_steps(p, 1, 2, grid, stream);
        naive_b0((char*)(A + 112 * MiB), 1, H, PROJ, QMr, KVMr, KCr, VCr, X0);
        C(dbg::K_QA, A + A_QA, PROJ, SEQ * 512, 0, 1.0f / QS_NSA, 1);
        C(dbg::K_KV, A + A_KC, PROJ, SEQ * 128, C_KC, 1.f, 2);
        C(dbg::K_KV, A + A_VC, PROJ, SEQ * 128, C_VC, 1.f, 3);
        C(dbg::K_KV, A + A_KS, PROJ, SEQ * 128, C_KS, 1.f, 4);
        C(dbg::K_KV, A + A_VS, PROJ, SEQ * 128, C_VS, 1.f, 5);
        C(dbg::K_KV, A + A_KW, PROJ, SEQ * 128, C_KW, 1.f, 6);
        C(dbg::K_KV, A + A_VW, PROJ, SEQ * 128, C_VW, 1.f, 7);
        C(dbg::K_GATES, A + A_GATES, PROJ, SEQ * 24, 0, 1.f, 8);
        C(dbg::K_CQ, A + A_CQKV, PROJ, SEQ * 256, 0, 1.f, 9);
        C(dbg::K_CKV, A + A_CQKV, PROJ, SEQ * 128, 0, 1.f, 10);
        C(dbg::K_KR, A + A_KR, PROJ, SEQ * 32, 0, 1.f, 11);
#if MK_DEBUG >= 2
        launch_steps(p, 2, 3, grid, stream); launch_steps(p, 3, 4, grid, stream); launch_steps(p, 4, 5, grid, stream);
        naive_b0((char*)A, 2, H, PROJ, QMr, KVMr, KCr, VCr, X0);
        C(dbg::K_QM, A + A_QM, QMr, SEQ * 768, 0, 1.0f / QS_MLA, 12);
        C(dbg::K_KN, A + A_KN, KVMr, SEQ * 512, 0, 1.f, 13);
        C(dbg::K_KN, A + A_VM, KVMr, SEQ * 512, 64, 1.f, 14);
        C(dbg::K_CMP, ws + WS_KCMP, KCr, 255 * 128, 0, 1.f, 15);
        C(dbg::K_CMP, ws + WS_VCMP, VCr, 255 * 128, 0, 1.f, 16);
        C(dbg::K_OAB, ws + WS_OAB, H, SEQ * 512, 512, 1.f, 17);
        C(dbg::K_OAB, ws + WS_OAB, H, SEQ * 512, 0, 1.f, 18);
#endif
#if MK_DEBUG >= 3
        launch_steps(p, 5, 6, grid, stream); launch_steps(p, 6, 7, grid, stream);
        rmsnorm_rows<<<SEQ / 4, 256, 0, stream>>>(H, 1024, (const float*)d_in[13], H, 1024, 512, SEQ);
        rmsnorm_rows<<<SEQ / 4, 256, 0, stream>>>(H + 512, 1024, (const float*)d_in[14], H + 512, 1024, 512, SEQ);
        sgemm128<1><<<dim3(D_MODEL / 128, SEQ / 128), 256, 0, stream>>>(H, 1024, (const float*)d_in[15], 1024, X0, 1024, x_in, 1024, SEQ, 1024, 1024);
        C(dbg::K_X, d_out, X0, SEQ * 1024, 0, 1.f, 19);
        {
            float* XF = (float*)(ws + WS_END); float* HIDn = (float*)(ws + WS_OAB);
            rmsnorm_rows<<<SEQ / 4, 256, 0, stream>>>(X0, D_MODEL, (const float*)d_in[16], H, D_MODEL, D_MODEL, SEQ);
            sgemm128<2><<<dim3(D_FF / 128, SEQ / 128), 256, 0, stream>>>(H, 1024, (const float*)d_in[17], 4096, HIDn, 4096, nullptr, 0, SEQ, 4096, 1024);
            sgemm128<1><<<dim3(D_MODEL / 128, SEQ / 128), 256, 0, stream>>>(HIDn, 4096, (const float*)d_in[18], 1024, XF, 1024, X0, 1024, SEQ, 1024, 4096);
            launch_steps(p, 7, 8, grid, stream); launch_steps(p, 8, 9, grid, stream);
            C(dbg::K_X, d_out, XF, SEQ * 1024, 0, 1.f, 20);
        }
#endif
        naive_forward(d_in, (float*)d_out, (char*)ws + 4 * MiB, stream);
#ifndef MK_DBG_ID
#define MK_DBG_ID 0
#endif
        dbg::encode_kernel<<<(NTOK * D_MODEL + 255) / 256, 256, 0, stream>>>((float*)d_out, (size_t)NTOK * D_MODEL, err, 20, MK_DBG_ID);
    }
#endif
}
```

```cpp
#define MK_DEBUG 0
#include <hip/hip_runtime.h>
#include <cstdint>
#include <cstddef>
#define LAS __attribute__((address_space(3)))
#define GAS __attribute__((address_space(1)))
#define DI __device__ __forceinline__

typedef unsigned short bf16_t;
typedef short bf16x8 __attribute__((ext_vector_type(8)));
typedef short s16x4 __attribute__((ext_vector_type(4)));
typedef short v4i16_t __attribute__((ext_vector_type(4)));
typedef float f32x2 __attribute__((ext_vector_type(2)));
typedef float f32x4 __attribute__((ext_vector_type(4)));
typedef float f32x16 __attribute__((ext_vector_type(16)));
typedef unsigned u32x2 __attribute__((ext_vector_type(2)));
typedef unsigned u32x4 __attribute__((ext_vector_type(4)));
typedef __bf16 bf16x2_t __attribute__((ext_vector_type(2)));

namespace mk {

constexpr int D_MODEL = 1024, BATCH = 8, SEQ = 4096, DEPTH = 4, NTOK = BATCH * SEQ, IN_WIDTH = 1720, D_FF = 4096;
constexpr int NPROJ = 1792, NUP = 1792, KUP = 384;
constexpr float NORM_EPS = 1e-6f;
constexpr float LOG2E = 1.4426950408889634f;
constexpr float QS_NSA = 0.125f * LOG2E;
constexpr float QS_MLA = 0.10206207261596575f * LOG2E;
constexpr int NWAVES = 8, NTHR = 512;

constexpr size_t MiB = 1u << 20;
constexpr size_t WS_CTL = 0, CTL_BYTES = 4 * MiB;
constexpr int CW_BAR = 4096;
constexpr int CW_QUEUE = 8192;
constexpr size_t WS_SSCQ = 1 * MiB  , WS_SSCKV = 1 * MiB + 512 * 1024  , WS_SS1 = 492 * MiB  , WS_SS2 = 494 * MiB  ,
                 WS_SSA = 2 * MiB  , WS_SSB = 3 * MiB  ;
constexpr size_t WS_W = 4 * MiB;
constexpr size_t W_WIN = 0, W_W1K = 14 * MiB, W_W1V = 18 * MiB, W_WUP = 22 * MiB  , W_WOUT = 28 * MiB, W_WFF1 = 36 * MiB, W_WFF2 = 68 * MiB;
constexpr size_t SZ_WIN = (size_t)NPROJ * 1024 * 2, SZ_W1 = (size_t)256 * 2048 * 2, SZ_WUP = (size_t)NUP * KUP * 2, SZ_WOUT = (size_t)1024 * 1024 * 2, SZ_WFF = (size_t)4096 * 1024 * 2;
constexpr size_t W_TAB = 100 * MiB;
constexpr size_t W_COSA = W_TAB, W_SINA = W_TAB + 512 * 1024, W_COSB = W_TAB + 1024 * 1024, W_SINB = W_TAB + 1280 * 1024, W_BIAS1 = W_TAB + 1536 * 1024;
constexpr size_t WS_XB = 106 * MiB;
constexpr size_t WS_OAB = 170 * MiB;
constexpr size_t WS_KCMP = 234 * MiB, WS_VCMP = 234 * MiB + 512 * 1024;
constexpr size_t WS_A = 236 * MiB;
constexpr size_t KVSLOT = 8 * MiB + 64 * 1024;
constexpr size_t A_QA = 0, A_KC = 32 * MiB, A_VC = A_KC + KVSLOT, A_KS = A_VC + KVSLOT, A_VS = A_KS + KVSLOT, A_KW = A_VS + KVSLOT, A_VW = A_KW + KVSLOT;
constexpr size_t A_GATES = 81 * MiB, A_CQKV = 84 * MiB  , A_KR = 108 * MiB  , A_QM = 110 * MiB  , A_KN = 158 * MiB, A_VM = 190 * MiB, A_HIDC = 222 * MiB  ;
constexpr size_t A_MIX = A_QM;
constexpr size_t WS_END = WS_A + 256 * MiB + 4 * MiB;
static_assert(WS_W + W_TAB + 2 * MiB <= WS_XB && WS_XB + 64 * MiB <= WS_OAB && WS_OAB + 64 * MiB <= WS_KCMP && WS_VCMP + 512 * 1024 <= WS_A && WS_SS1 == WS_A + 256 * MiB, "ws map");
static_assert(A_VW + KVSLOT <= A_GATES && A_HIDC + 32 * MiB <= 256 * MiB, "A map");

constexpr int LDS_SCRATCH = 131072, LDS_MISC = 131072, LDS_BYTES = 147456;

struct Params {
    const float* in[20];
    float* out;
    unsigned char* ws;
    int s_lo, s_hi;
};

DI unsigned cvtpk(float lo, float hi) { f32x2 v = {lo, hi}; bf16x2_t b = __builtin_convertvector(v, bf16x2_t); return __builtin_bit_cast(unsigned, b); }
DI float bf2f(bf16_t v) { return __builtin_bit_cast(float, (unsigned)v << 16); }
DI float ex2(float x) { return __builtin_amdgcn_exp2f(x); }
DI float wsum(float v) {
#pragma unroll
    for (int o = 1; o < 64; o <<= 1) v += __shfl_xor(v, o);
    return v;
}
DI int crow(int i, int h) { return (i & 3) + 8 * (i >> 2) + 4 * h; }
DI unsigned char* launder(unsigned char* p) { asm volatile("" : "+s"(p)); return p; }
DI const float* launder(const float* p) { asm volatile("" : "+s"(p)); return p; }
DI int launder_v(int v) { asm volatile("" : "+v"(v)); return v; }
DI int launder_s(int v) { asm volatile("" : "+s"(v)); return v; }
DI int lane_id_now() { int l; asm volatile("v_mbcnt_lo_u32_b32 %0, -1, 0\n\tv_mbcnt_hi_u32_b32 %0, -1, %0" : "=v"(l)); return l; }

#define XB_TMO      128
#define XB_XCNT(j)  (256  + 64 * (j))
#define XB_XSUB(j)  (1280 + 64 * (j))
#define XB_XGEN(j)  (2304 + 64 * (j))
#define XB_TOP      3328
#define XB_TOPGEN   3392
#define XCD_BAR_WORDS 3456
#define XB_SPIN_CAP (1u << 20)
DI unsigned xb_ld(unsigned* p)              { return __hip_atomic_load(p, __ATOMIC_RELAXED, __HIP_MEMORY_SCOPE_AGENT); }
DI unsigned xb_add(unsigned* p, unsigned v) { return __hip_atomic_fetch_add(p, v, __ATOMIC_RELAXED, __HIP_MEMORY_SCOPE_AGENT); }
DI unsigned xb_xcc_id() { return (unsigned)__builtin_amdgcn_s_getreg((3 << 11) | 20) & 0xFu; }
#define XB_SPIN(cond, bar) do { unsigned _sp = 0; while (cond) { __builtin_amdgcn_s_sleep(4); \
    if ((++_sp & 255u) == 0u) { if (xb_ld(&(bar)[XB_TMO])) break; if (_sp > XB_SPIN_CAP) { atomicAdd(&(bar)[XB_TMO], 1u); break; } } } } while (0)
struct XcdBarrier { unsigned* bar; unsigned x; volatile LAS unsigned* st; int wave; };
DI XcdBarrier xcd_barrier_post(unsigned* bar, volatile LAS unsigned* st) {
    XcdBarrier b; b.bar = bar; b.x = xb_xcc_id(); b.st = st; b.wave = __builtin_amdgcn_readfirstlane((int)threadIdx.x >> 6);
    if (threadIdx.x == 0) (void)xb_add(&bar[XB_XCNT(b.x)], 1u);
    return b;
}
DI void xcd_barrier_complete(unsigned* bar, unsigned x_, unsigned& nloc, unsigned& nx) {
    unsigned x = x_; asm volatile("" : "+s"(x));
    const unsigned G = gridDim.x * gridDim.y * gridDim.z;
    unsigned sum, cnt, mine, sp = 0u;
    for (;;) {
        sum = 0u; cnt = 0u; mine = 0u;
#pragma unroll
        for (unsigned j = 0; j < 16; ++j) { const unsigned c = xb_ld(&bar[XB_XCNT(j)]); sum += c; cnt += (c > 0u) ? 1u : 0u; mine = (j == x) ? c : mine; }
        if (sum == G) break;
        __builtin_amdgcn_s_sleep(1);
        if ((++sp & 255u) == 0u) { if (xb_ld(&bar[XB_TMO])) break; if (sp > XB_SPIN_CAP) { atomicAdd(&bar[XB_TMO], 1u); break; } }
    }
    nloc = mine > 0u ? mine : 1u; nx = cnt > 0u ? cnt : 1u;
}
DI void xcd_barrier(const XcdBarrier& b) {
    asm volatile("s_waitcnt vmcnt(0)" ::: "memory");
    __syncthreads();
    int wv_ = b.wave; asm volatile("" : "+s"(wv_));
    if (wv_ == 0 && lane_id_now() == 0) {
        unsigned* bar = (unsigned*)launder((unsigned char*)b.bar);
        __builtin_amdgcn_s_waitcnt(0);
        unsigned nloc = b.st[0], nx = b.st[1];
        if (nloc == 0u) { xcd_barrier_complete(bar, b.x, nloc, nx); b.st[0] = nloc; b.st[1] = nx; }
        const unsigned old = xb_add(&bar[XB_XSUB(b.x)], 1u);
        const unsigned gen = old / nloc;
        if (old + 1u == (gen + 1u) * nloc) {
            __builtin_amdgcn_fence(__ATOMIC_RELEASE, "agent");
            asm volatile("s_waitcnt vmcnt(0)" ::: "memory");
            const unsigned og = xb_add(&bar[XB_TOP], 1u);
            const unsigned tg = og / nx;
            if (og + 1u == (tg + 1u) * nx) xb_add(&bar[XB_TOPGEN], 1u);
            else XB_SPIN(xb_ld(&bar[XB_TOPGEN]) == tg, bar);
            __builtin_amdgcn_fence(__ATOMIC_ACQUIRE, "agent");
            xb_add(&bar[XB_XGEN(b.x)], 1u);
            asm volatile("s_waitcnt vmcnt(0)" ::: "memory");
        } else {
            XB_SPIN(xb_ld(&bar[XB_XGEN(b.x)]) == gen, bar);
            __builtin_amdgcn_fence(__ATOMIC_ACQUIRE, "agent");
            asm volatile("s_waitcnt vmcnt(0)" ::: "memory");
        }
    }
    __syncthreads();
}

namespace pg8 {
constexpr int BM = 256, BK = 64, HALF = 128, HTB = HALF * BK * 2, STAGE_BYTES = 8 * HTB, NXCD = 8, WGM = 8;
DI int lds_byte(int r, int c) { const int st = (r >> 4) * 2 + (c >> 5), rr = r & 15, cc = c & 31, ob = rr * 64 + cc * 2; return st * 1024 + (ob ^ (((ob >> 9) & 1) << 5)); }
DI int perm32(int rho) { const int n = rho >> 4, i = rho & 15; return 8 * (i >> 2) + 4 * n + (i & 3); }
DI void stage_rc(int b, int& R, int& C) { const int st = b / 1024, sb = b % 1024, swz = sb ^ (((sb >> 9) & 1) << 5); R = (st >> 1) * 16 + swz / 64; C = (st & 1) * 32 + (swz % 64) / 2; }
struct Unit { int pm, pn; };
struct Gemm { const bf16_t* A; const bf16_t* Bt; int M, N, K, lda, ldb; };
struct StaticOrder {
    int nM, nN, nwg, G, c;
    DI void init(int M, int N, int G_, int c_) { nM = M / BM; nN = N / BM; nwg = nM * nN; G = G_; c = c_; }
    DI bool next(int i, Unit& u) const {
        const long L = (long)i * G + c; if (c < 0 || L >= nwg) return false;
        int wgid = (int)L; { const int q = nwg / NXCD, r = nwg % NXCD, xcd = wgid % NXCD, off = wgid / NXCD; wgid = (xcd < r ? xcd * (q + 1) : r * (q + 1) + (xcd - r) * q) + off; }
        const int nig = WGM * nN, gid = wgid / nig, fm = gid * WGM, gsz = (nM - fm) < WGM ? (nM - fm) : WGM;
        u.pm = fm + ((wgid % nig) % gsz); u.pn = (wgid % nig) / gsz; return true;
    }
};

template <class Epi, class Sched>
DI void gemm_phase(LAS unsigned char* lds, const Gemm g, const Sched& S, const Epi& E, int wave0) {
    const int lane = lane_id_now(), wid = wave0, tid = wid * 64 + lane, wr = wid >> 2, wc = wid & 3, fr = lane & 15, fq = lane >> 4;
    const int K = g.K, nt = K / BK;
    unsigned voffA[2], voffB[2];
#pragma unroll
    for (int i = 0; i < 2; ++i) { int R, C; stage_rc(tid * 16 + i * 8192, R, C);
        const int g_ = R >> 5, Rb = Epi::PERM == 2 ? ((g_ & 3) * 64 + (g_ >> 2) * 32 + perm32(R & 31))
                                   : Epi::PERM ? ((R & ~31) + perm32(R & 31)) : R;
        voffA[i] = (unsigned)(R * g.lda + C) * 2u; voffB[i] = (unsigned)(Rb * g.ldb + C) * 2u; }
    const size_t kstep = (size_t)(BK * 2);
    const size_t hstepA = (size_t)HALF * g.lda * 2, hstepB = (size_t)(Epi::PERM == 2 ? 32 : HALF) * g.ldb * 2;
    const size_t tstepA = 2 * hstepA, tstepB = (size_t)2 * HALF * g.ldb * 2;
    const unsigned ldsw = (unsigned)wid * 1024u;
    const int aoff = lds_byte(wr * 64 + fr, fq * 8), boff = lds_byte(wc * 32 + fr, fq * 8);
#define PG8_SA(b, h) (((b) * 2 + (h)) * HTB)
#define PG8_SB(b, h) ((4 + (b) * 2 + (h)) * HTB)
#define PG8_STAGE(bufoff, gbase, voff) do { _Pragma("unroll") for (int _i = 0; _i < 2; ++_i) \
        __builtin_amdgcn_global_load_lds((const unsigned*)((const char*)(gbase) + (voff)[_i]), (LAS unsigned*)(lds + (bufoff) + ldsw + _i * 8192), 16, 0, 0); } while (0)
#define PG8_LDA(dst, b, h) do { _Pragma("unroll") for (int m = 0; m < 4; ++m) _Pragma("unroll") for (int k = 0; k < 2; ++k) dst[m][k] = *(const LAS bf16x8*)(lds + PG8_SA(b, h) + aoff + m * 2048 + k * 1024); } while (0)
#define PG8_LDB(dst, b, h) do { _Pragma("unroll") for (int n = 0; n < 2; ++n) _Pragma("unroll") for (int k = 0; k < 2; ++k) dst[n][k] = *(const LAS bf16x8*)(lds + PG8_SB(b, h) + boff + n * 2048 + k * 1024); } while (0)
#define PG8_MMA(ai, bj, At, Bt) do { __builtin_amdgcn_s_setprio(1); _Pragma("unroll") for (int m = 0; m < 4; ++m) _Pragma("unroll") for (int n = 0; n < 2; ++n) _Pragma("unroll") for (int k = 0; k < 2; ++k) \
        acc[ai][bj][m][n] = __builtin_amdgcn_mfma_f32_16x16x32_bf16(Bt[n][k], At[m][k], acc[ai][bj][m][n], 0, 0, 0); __builtin_amdgcn_s_setprio(0); } while (0)
#define PG8_WAIT_V(n) asm volatile("s_waitcnt vmcnt(" #n ")" ::: "memory")
#define PG8_WAIT_L(n) asm volatile("s_waitcnt lgkmcnt(" #n ")" ::: "memory")
#define PG8_BAR __builtin_amdgcn_s_barrier()
#define PG8_SCHED __builtin_amdgcn_sched_barrier(0)
    Unit cur, nxt; int ui = 0;
    if (!S.next(0, cur)) return;
    f32x4 acc[2][2][4][2];
#pragma unroll
    for (int a = 0; a < 2; ++a)
#pragma unroll
        for (int b = 0; b < 2; ++b)
#pragma unroll
            for (int m = 0; m < 4; ++m)
#pragma unroll
                for (int n = 0; n < 2; ++n) acc[a][b][m][n] = (f32x4){0.f, 0.f, 0.f, 0.f};
    bf16x8 At[4][2], B0[2][2], B1[2][2];
    const char* cA = (const char*)g.A + (size_t)cur.pm * tstepA; const char* cB = (const char*)g.Bt + (size_t)cur.pn * tstepB;
    PG8_STAGE(PG8_SB(0, 0), cB, voffB); PG8_STAGE(PG8_SB(0, 1), cB + hstepB, voffB); PG8_STAGE(PG8_SA(0, 0), cA, voffA); PG8_STAGE(PG8_SA(0, 1), cA + hstepA, voffA);
    if (wr == 1) PG8_BAR;
    PG8_WAIT_V(2); PG8_BAR;
    PG8_STAGE(PG8_SB(1, 0), cB + kstep, voffB); PG8_STAGE(PG8_SA(1, 0), cA + kstep, voffA); PG8_STAGE(PG8_SB(1, 1), cB + hstepB + kstep, voffB);
    PG8_WAIT_V(6); PG8_BAR;
    for (;;) {
        const bool has_next = S.next(ui + 1, nxt);
        const char* nA = has_next ? (const char*)g.A + (size_t)nxt.pm * tstepA : cA; const char* nB = has_next ? (const char*)g.Bt + (size_t)nxt.pn * tstepB : cB;
#pragma unroll 1
        for (int t = 0; t < nt; t += 2) {
            if constexpr (Epi::MID) { if (t == nt / 2) E.mid(acc, cur, wr, wc, fr, fq); }
            const bool last = (t == nt - 2);
            const char* a1 = cA + (size_t)(t + 1) * kstep;
            const char* a2 = last ? nA : cA + (size_t)(t + 2) * kstep; const char* b2 = last ? nB : cB + (size_t)(t + 2) * kstep;
            const char* a3 = a2 + kstep; const char* b3 = b2 + kstep;
            PG8_LDB(B0, 0, 0); PG8_LDB(B1, 0, 1); PG8_SCHED; PG8_LDA(At, 0, 0); PG8_STAGE(PG8_SA(1, 1), a1 + hstepA, voffA);
            PG8_WAIT_V(8); PG8_WAIT_L(0); PG8_BAR; PG8_MMA(0, 0, At, B0); PG8_MMA(0, 1, At, B1); PG8_BAR; PG8_SCHED;
            PG8_LDA(At, 0, 1); PG8_STAGE(PG8_SB(0, 0), b2, voffB); PG8_STAGE(PG8_SB(0, 1), b2 + hstepB, voffB); PG8_STAGE(PG8_SA(0, 0), a2, voffA);
            PG8_WAIT_V(8); PG8_WAIT_L(0); PG8_BAR; PG8_MMA(1, 0, At, B0); PG8_MMA(1, 1, At, B1); PG8_BAR; PG8_SCHED;
            PG8_LDB(B0, 1, 0); PG8_LDB(B1, 1, 1); PG8_SCHED; PG8_LDA(At, 1, 0); PG8_STAGE(PG8_SA(0, 1), a2 + hstepA, voffA);
            PG8_WAIT_V(8); PG8_WAIT_L(0); PG8_BAR; PG8_MMA(0, 0, At, B0); PG8_MMA(0, 1, At, B1); PG8_BAR; PG8_SCHED;
            PG8_LDA(At, 1, 1); PG8_STAGE(PG8_SB(1, 0), b3, voffB); PG8_STAGE(PG8_SB(1, 1), b3 + hstepB, voffB); PG8_STAGE(PG8_SA(1, 0), a3, voffA);
            PG8_WAIT_V(8); PG8_WAIT_L(0); PG8_BAR; PG8_MMA(1, 0, At, B0); PG8_MMA(1, 1, At, B1); PG8_BAR; PG8_SCHED;
        }
        if (wr == 0) PG8_BAR;
        E(acc, cur, wr, wc, fr, fq);
#ifdef MK_EPI2
        if constexpr (Epi::EPI2) E(acc, cur, wr, wc, fr, fq);
#endif
        if (!has_next) break;
#pragma unroll
        for (int a = 0; a < 2; ++a)
#pragma unroll
            for (int b = 0; b < 2; ++b)
#pragma unroll
                for (int m = 0; m < 4; ++m)
#pragma unroll
                    for (int n = 0; n < 2; ++n) acc[a][b][m][n] = (f32x4){0.f, 0.f, 0.f, 0.f};
        cur = nxt; cA = nA; cB = nB; ++ui;
        if (wr == 1) PG8_BAR;
    }
    PG8_WAIT_V(0);
    PG8_BAR;
#undef PG8_SA
#undef PG8_SB
#undef PG8_STAGE
#undef PG8_LDA
#undef PG8_LDB
#undef PG8_MMA
#undef PG8_WAIT_V
#undef PG8_WAIT_L
#undef PG8_BAR
#undef PG8_SCHED
}
}

using pg8::Unit;
typedef f32x4 AccT[2][2][4][2];

DI void st_bf4(bf16_t* p, f32x4 v) { u32x2 w; w.x = cvtpk(v[0], v[1]); w.y = cvtpk(v[2], v[3]); *(GAS u32x2*)p = w; }
DI float sq4(f32x4 v) { return (v[0] * v[0] + v[1] * v[1]) + (v[2] * v[2] + v[3] * v[3]); }
DI float st_bf4_sq(bf16_t* p, f32x4 v) { u32x2 w; w.x = cvtpk(v[0], v[1]); w.y = cvtpk(v[2], v[3]); *(GAS u32x2*)p = w;
    const float a = __builtin_bit_cast(float, w[0] << 16), b = __builtin_bit_cast(float, w[0] & 0xffff0000u), c = __builtin_bit_cast(float, w[1] << 16), d = __builtin_bit_cast(float, w[1] & 0xffff0000u);
    return (a * a + b * b) + (c * c + d * d); }
DI float st_row64(bf16_t* rowp, const f32x16& o0, const f32x16& o1, float scale, int h) {
    float ssq = 0.f; u32x2 pc[8];
#pragma unroll
    for (int g = 0; g < 8; ++g) { const f32x16& o = g < 4 ? o0 : o1; const int b4 = (g & 3) * 4;
        u32x2 w; w.x = cvtpk(o[b4] * scale, o[b4 + 1] * scale); w.y = cvtpk(o[b4 + 2] * scale, o[b4 + 3] * scale); pc[g] = w;
        const float a = __builtin_bit_cast(float, w[0] << 16), b = __builtin_bit_cast(float, w[0] & 0xffff0000u), c = __builtin_bit_cast(float, w[1] << 16), d = __builtin_bit_cast(float, w[1] & 0xffff0000u);
        ssq += (a * a + b * b) + (c * c + d * d); }
#pragma unroll
    for (int k = 0; k < 4; ++k) {
        const u32x2 snd = h ? pc[2 * k] : pc[2 * k + 1]; u32x2 rcv;
        rcv.x = (unsigned)__shfl_xor((int)snd.x, 32); rcv.y = (unsigned)__shfl_xor((int)snd.y, 32);
        u32x4 out; if (h) { out.x = rcv.x; out.y = rcv.y; out.z = pc[2 * k + 1].x; out.w = pc[2 * k + 1].y; } else { out.x = pc[2 * k].x; out.y = pc[2 * k].y; out.z = rcv.x; out.w = rcv.y; }
        *(GAS u32x4*)(rowp + 16 * k + (h ? 8 : 0)) = out; }
    return ssq;
}
DI float sum16(const float* p) { const f32x4 a = *(const GAS f32x4*)p, b = *(const GAS f32x4*)(p + 4), c = *(const GAS f32x4*)(p + 8), d = *(const GAS f32x4*)(p + 12);
    return (((a[0] + a[1]) + (a[2] + a[3])) + ((b[0] + b[1]) + (b[2] + b[3]))) + (((c[0] + c[1]) + (c[2] + c[3])) + ((d[0] + d[1]) + (d[2] + d[3]))); }
DI float sum16_q(const float* p, int fq) { const f32x4 a = *(const GAS f32x4*)(p + 4 * fq); float s = (a[0] + a[1]) + (a[2] + a[3]); s += __shfl_xor(s, 16); s += __shfl_xor(s, 32); return s; }
DI float sum4(const float* p) { const f32x4 a = *(const GAS f32x4*)p; return (a[0] + a[1]) + (a[2] + a[3]); }

DI void st_bf8(bf16_t* p, f32x4 a, f32x4 b) { u32x4 w; w.x = cvtpk(a[0], a[1]); w.y = cvtpk(a[2], a[3]); w.z = cvtpk(b[0], b[1]); w.w = cvtpk(b[2], b[3]); *(GAS u32x4*)p = w; }
struct EpiInProj {
    static constexpr bool MID = false; static constexpr bool EPI2 = false; static constexpr bool PERM = true;
    unsigned char* ws_; int l;
    DI void operator()(const AccT& acc, const Unit& u, int wr, int wc, int fr, int fq) const {
        unsigned char* ws = launder(ws_);
        unsigned char* A = ws + WS_A;
        const float* ss1 = (const float*)(ws + WS_SS1); float* sscq = (float*)(ws + WS_SSCQ); float* ssckv = (float*)(ws + WS_SSCKV);
        bf16_t* QA = (bf16_t*)(A + A_QA); bf16_t* KC = (bf16_t*)(A + A_KC); bf16_t* VC = (bf16_t*)(A + A_VC); bf16_t* CQKV = (bf16_t*)(A + A_CQKV); bf16_t* KR = (bf16_t*)(A + A_KR); float* GATES = (float*)(A + A_GATES);
        const float* cosA = (const float*)(ws + WS_W + W_COSA); const float* sinA = (const float*)(ws + WS_W + W_SINA); const float* cosB = (const float*)(ws + WS_W + W_COSB); const float* sinB = (const float*)(ws + WS_W + W_SINB);
        const int pn = u.pn;
#pragma unroll
        for (int ai = 0; ai < 2; ++ai)
#pragma unroll
            for (int m = 0; m < 4; ++m) {
                const int row = u.pm * 256 + ai * 128 + wr * 64 + m * 16 + fr, t = row & (SEQ - 1), b = row >> 12;
                const float rstd = rsqrtf(sum16_q(ss1 + (size_t)row * 16, fq) * (1.0f / 1024.0f) + NORM_EPS);
                if (pn < 5) {
                    const bool roped = pn < 2 || wc < 2;
                    if (roped) {
                        const f32x4 c0 = *(const GAS f32x4*)(cosA + t * 32 + 8 * fq), c1 = *(const GAS f32x4*)(cosA + t * 32 + 8 * fq + 4);
                        const f32x4 s0 = *(const GAS f32x4*)(sinA + t * 32 + 8 * fq), s1 = *(const GAS f32x4*)(sinA + t * 32 + 8 * fq + 4);
                        const f32x4 l0 = acc[ai][0][m][0] * rstd, l1 = acc[ai][0][m][1] * rstd, h0 = acc[ai][1][m][0] * rstd, h1 = acc[ai][1][m][1] * rstd;
                        bf16_t* dst; float sc;
                        if (pn < 2) { dst = QA + (size_t)row * 512 + (pn * 4 + wc) * 64 + 8 * fq; sc = QS_NSA; }
                        else { dst = KC + (size_t)(pn - 2) * KVSLOT + ((size_t)(b * 2 + wc) * SEQ + t) * 64 + 8 * fq; sc = 1.0f; }
                        st_bf8(dst, (l0 * c0 - h0 * s0) * sc, (l1 * c1 - h1 * s1) * sc);
                        st_bf8(dst + 32, (h0 * c0 + l0 * s0) * sc, (h1 * c1 + l1 * s1) * sc);
                    } else {
                        bf16_t* dst = VC + (size_t)(pn - 2) * KVSLOT + ((size_t)(b * 2 + (wc - 2)) * SEQ + t) * 64 + 8 * fq;
                        st_bf8(dst, acc[ai][0][m][0] * rstd, acc[ai][0][m][1] * rstd);
                        st_bf8(dst + 32, acc[ai][1][m][0] * rstd, acc[ai][1][m][1] * rstd);
                    }
                } else if (pn == 5) {
                    float q = 0.f;
#pragma unroll
                    for (int bj = 0; bj < 2; ++bj) { const f32x4 x0 = acc[ai][bj][m][0] * rstd, x1 = acc[ai][bj][m][1] * rstd; q += sq4(x0) + sq4(x1); st_bf8(CQKV + (size_t)row * KUP + bj * 128 + wc * 32 + 8 * fq, x0, x1); }
                    q += __shfl_xor(q, 16); q += __shfl_xor(q, 32);
                    if (fq == 0) sscq[(size_t)row * 4 + wc] = q;
                } else {
                    { const f32x4 x0 = acc[ai][0][m][0] * rstd, x1 = acc[ai][0][m][1] * rstd; float q = sq4(x0) + sq4(x1); st_bf8(CQKV + (size_t)row * KUP + 256 + wc * 32 + 8 * fq, x0, x1);
                      q += __shfl_xor(q, 16); q += __shfl_xor(q, 32);
                      if (fq == 0) ssckv[(size_t)row * 4 + wc] = q; }
                    if (wc == 0) {
                        const f32x4 c4 = *(const GAS f32x4*)(cosB + t * 16 + 4 * fq), s4 = *(const GAS f32x4*)(sinB + t * 16 + 4 * fq);
                        const f32x4 x0 = acc[ai][1][m][0] * rstd, x1 = acc[ai][1][m][1] * rstd;
                        bf16_t* dst = KR + (size_t)row * 32 + 4 * fq;
                        st_bf4(dst, x0 * c4 - x1 * s4); st_bf4(dst + 16, x1 * c4 + x0 * s4);
                    } else if (wc == 1 && fq < 3) {
#pragma unroll
                        for (int n = 0; n < 2; ++n) { const f32x4 x = acc[ai][1][m][n] * rstd; f32x4 sg;
#pragma unroll
                            for (int j = 0; j < 4; ++j) sg[j] = 1.0f / (1.0f + __expf(-x[j]));
                            *(GAS f32x4*)(GATES + (size_t)row * 24 + 8 * fq + 4 * n) = sg; }
                    }
                }
                if (m == 3) asm volatile("" ::: "memory");
            }
    }
};

struct EpiUp {
    static constexpr bool MID = false; static constexpr bool EPI2 = false; static constexpr bool PERM = true;
    unsigned char* ws_; int l;
    DI void operator()(const AccT& acc, const Unit& u, int wr, int wc, int fr, int fq) const {
        unsigned char* ws = launder(ws_);
        unsigned char* A = ws + WS_A;
        const int pn = u.pn;
        const float* ssp = (const float*)(ws + (pn < 3 ? WS_SSCQ : WS_SSCKV));
        const float ssdiv = pn < 3 ? (1.0f / 256.0f) : (1.0f / 128.0f), ssmul = pn < 3 ? QS_MLA : 1.0f;
        const int row0 = u.pm * 256 + wr * 64 + fr;
        if (pn < 2) {
            bf16_t* QM = (bf16_t*)(A + A_QM);
#pragma unroll
            for (int ai = 0; ai < 2; ++ai)
#pragma unroll
                for (int m = 0; m < 4; ++m) { const int row = row0 + ai * 128 + m * 16; const float sc = rsqrtf(sum4(ssp + (size_t)row * 4) * ssdiv + NORM_EPS) * ssmul;
#pragma unroll
                    for (int bj = 0; bj < 2; ++bj) { const int head = pn * 4 + bj * 2 + (wc >> 1);
                        st_bf8(QM + (size_t)row * 768 + head * 96 + 32 * (wc & 1) + 8 * fq, acc[ai][bj][m][0] * sc, acc[ai][bj][m][1] * sc); }
                    if (m == 3) asm volatile("" ::: "memory"); }
        } else if (pn == 2) {
            bf16_t* QM = (bf16_t*)(A + A_QM);
            const float* cosB = (const float*)(ws + WS_W + W_COSB); const float* sinB = (const float*)(ws + WS_W + W_SINB);
#pragma unroll
            for (int ai = 0; ai < 2; ++ai)
#pragma unroll
                for (int m = 0; m < 4; ++m) { const int row = row0 + ai * 128 + m * 16, t = row & (SEQ - 1); const float sc = rsqrtf(sum4(ssp + (size_t)row * 4) * ssdiv + NORM_EPS) * ssmul;
                    const f32x4 c4 = *(const GAS f32x4*)(cosB + t * 16 + 4 * fq), s4 = *(const GAS f32x4*)(sinB + t * 16 + 4 * fq);
#pragma unroll
                    for (int bj = 0; bj < 2; ++bj) { const int hd = bj * 4 + wc;
                        const f32x4 x0 = acc[ai][bj][m][0] * sc, x1 = acc[ai][bj][m][1] * sc;
                        bf16_t* dst = QM + (size_t)row * 768 + hd * 96 + 64 + 4 * fq;
                        st_bf4(dst, x0 * c4 - x1 * s4); st_bf4(dst + 16, x1 * c4 + x0 * s4); }
                    if (m == 3) asm volatile("" ::: "memory"); }
        } else {
            bf16_t* base = (bf16_t*)(A + (pn < 5 ? A_KN : A_VM)); const int pq = (pn < 5) ? pn - 3 : pn - 5;
#pragma unroll
            for (int ai = 0; ai < 2; ++ai)
#pragma unroll
                for (int m = 0; m < 4; ++m) { const int row = row0 + ai * 128 + m * 16, t = row & (SEQ - 1), b = row >> 12; const float sc = rsqrtf(sum4(ssp + (size_t)row * 4) * ssdiv + NORM_EPS);
#pragma unroll
                    for (int bj = 0; bj < 2; ++bj) { const int head = pq * 4 + bj * 2 + (wc >> 1);
                        st_bf8(base + ((size_t)(b * 8 + head) * SEQ + t) * 64 + 32 * (wc & 1) + 8 * fq, acc[ai][bj][m][0] * sc, acc[ai][bj][m][1] * sc); }
                    if (m == 3) asm volatile("" ::: "memory"); }
        }
    }
};

struct EpiSlab {
    static constexpr bool MID = false; static constexpr bool EPI2 = false; static constexpr bool PERM = true;
    unsigned char* ws_; int slab;
    DI void operator()(const AccT& acc, const Unit& u, int wr, int wc, int fr, int fq) const {
        float* S = (float*)(launder(ws_) + WS_A + A_HIDC) + (size_t)slab * 4096 * 256;
#pragma unroll
        for (int ai = 0; ai < 2; ++ai)
#pragma unroll
            for (int m = 0; m < 4; ++m) { const int row = u.pm * 256 + ai * 128 + wr * 64 + m * 16 + fr;
#pragma unroll
                for (int bj = 0; bj < 2; ++bj)
#pragma unroll
                    for (int n = 0; n < 2; ++n) *(GAS f32x4*)(S + (size_t)row * 256 + bj * 128 + wc * 32 + 8 * fq + 4 * n) = acc[ai][bj][m][n]; }
    }
};

template <bool NORM2>
struct EpiResid {
    static constexpr bool MID = NORM2; static constexpr bool EPI2 = false; static constexpr bool PERM = true;
    unsigned char* ws_; int ssi;
    DI static float rstd8(const float* p) { const f32x4 a = *(const GAS f32x4*)p, b = *(const GAS f32x4*)(p + 4);
        return rsqrtf((((a[0] + a[1]) + (a[2] + a[3])) + ((b[0] + b[1]) + (b[2] + b[3]))) * (1.0f / 512.0f) + NORM_EPS); }
    DI void mid(AccT& acc, const Unit& u, int wr, int wc, int fr, int fq) const {
        unsigned char* ws = launder(ws_); const float* ssa = (const float*)(ws + WS_SSA); const float* ssb = (const float*)(ws + WS_SSB);
#pragma unroll
        for (int ai = 0; ai < 2; ++ai)
#pragma unroll
            for (int m = 0; m < 4; ++m) { const int row = u.pm * 256 + ai * 128 + wr * 64 + m * 16 + fr;
                const float ratio = rstd8(ssa + (size_t)row * 8) / rstd8(ssb + (size_t)row * 8);
#pragma unroll
                for (int bj = 0; bj < 2; ++bj)
#pragma unroll
                    for (int n = 0; n < 2; ++n) acc[ai][bj][m][n] *= ratio;
                if (m & 1) asm volatile("" ::: "memory"); }
    }
    DI void operator()(const AccT& acc, const Unit& u, int wr, int wc, int fr, int fq) const {
        unsigned char* ws = launder(ws_);
        bf16_t* XB = (bf16_t*)(ws + WS_XB); float* ss = (float*)(ws + (ssi ? WS_SS2 : WS_SS1)); const float* ssb = (const float*)(ws + WS_SSB);
#pragma unroll
        for (int ai = 0; ai < 2; ++ai) {
            u32x4 old_[4][2]; float sc_[4];
#pragma unroll
            for (int m = 0; m < 4; ++m) { const int row = u.pm * 256 + ai * 128 + wr * 64 + m * 16 + fr;
#pragma unroll
                for (int bj = 0; bj < 2; ++bj) old_[m][bj] = *(const GAS u32x4*)(XB + (size_t)row * 1024 + u.pn * 256 + bj * 128 + wc * 32 + 8 * fq);
                sc_[m] = NORM2 ? rstd8(ssb + (size_t)row * 8) : 1.0f; }
#pragma unroll
            for (int m = 0; m < 4; ++m) { const int row = u.pm * 256 + ai * 128 + wr * 64 + m * 16 + fr; float q = 0.f;
                const float sc = sc_[m];
#pragma unroll
                for (int bj = 0; bj < 2; ++bj) { const size_t off = (size_t)row * 1024 + u.pn * 256 + bj * 128 + wc * 32 + 8 * fq;
                    const u32x4 o = old_[m][bj];
                    f32x4 x0, x1;
                    x0[0] = __builtin_bit_cast(float, o[0] << 16); x0[1] = __builtin_bit_cast(float, o[0] & 0xffff0000u); x0[2] = __builtin_bit_cast(float, o[1] << 16); x0[3] = __builtin_bit_cast(float, o[1] & 0xffff0000u);
                    x1[0] = __builtin_bit_cast(float, o[2] << 16); x1[1] = __builtin_bit_cast(float, o[2] & 0xffff0000u); x1[2] = __builtin_bit_cast(float, o[3] << 16); x1[3] = __builtin_bit_cast(float, o[3] & 0xffff0000u);
                    x0 += NORM2 ? acc[ai][bj][m][0] * sc : acc[ai][bj][m][0]; x1 += NORM2 ? acc[ai][bj][m][1] * sc : acc[ai][bj][m][1];
                    u32x4 w; w.x = cvtpk(x0[0], x0[1]); w.y = cvtpk(x0[2], x0[3]); w.z = cvtpk(x1[0], x1[1]); w.w = cvtpk(x1[2], x1[3]); *(GAS u32x4*)(XB + off) = w;
#pragma unroll
                    for (int j = 0; j < 4; ++j) { const float a = __builtin_bit_cast(float, w[j] << 16), b = __builtin_bit_cast(float, w[j] & 0xffff0000u); q += a * a + b * b; } }
                q += __shfl_xor(q, 16); q += __shfl_xor(q, 32);
                if (fq == 0) ss[(size_t)row * 16 + u.pn * 4 + wc] = q; }
            asm volatile("" ::: "memory"); }
    }
};

struct EpiFF1 {
    static constexpr bool MID = false; static constexpr bool EPI2 = true; static constexpr int PERM = 2;
    unsigned char* ws_; int l;
    mutable float rs_[8]; mutable int pm_ = -1;
    DI void operator()(const AccT& acc, const Unit& u, int wr, int wc, int fr, int fq) const {
        unsigned char* ws = launder(ws_); const float* ss2 = (const float*)(ws + WS_SS2); bf16_t* HID = (bf16_t*)(ws + WS_A);
        if (u.pm != pm_) {
            pm_ = u.pm;
#pragma unroll
            for (int g = 0; g < 8; ++g) { const int row = u.pm * 256 + (g >> 2) * 128 + wr * 64 + (g & 3) * 16 + fr;
                rs_[g] = rsqrtf(sum16_q(ss2 + (size_t)row * 16, fq) * (1.0f / 1024.0f) + NORM_EPS);
                if ((g & 3) == 3) asm volatile("" ::: "memory"); }
        }
        const bool hi = (fr & 8) != 0;
#pragma unroll
        for (int ai = 0; ai < 2; ++ai)
#pragma unroll
            for (int m = 0; m < 4; ++m) { const int row8 = u.pm * 256 + ai * 128 + wr * 64 + m * 16 + (fr & 7);
                const float rstd = rs_[ai * 4 + m];
                u32x4 w[2];
#pragma unroll
                for (int bj = 0; bj < 2; ++bj) { f32x4 x0 = acc[ai][bj][m][0] * rstd, x1 = acc[ai][bj][m][1] * rstd;
#pragma unroll
                    for (int j = 0; j < 4; ++j) { const float r0 = fmaxf(x0[j], 0.f), r1 = fmaxf(x1[j], 0.f); x0[j] = r0 * r0; x1[j] = r1 * r1; }
                    w[bj].x = cvtpk(x0[0], x0[1]); w[bj].y = cvtpk(x0[2], x0[3]); w[bj].z = cvtpk(x1[0], x1[1]); w[bj].w = cvtpk(x1[2], x1[3]); }
                u32x4 rcv, va, vb;
#pragma unroll
                for (int j = 0; j < 4; ++j) { const unsigned snd = hi ? w[0][j] : w[1][j];
                    rcv[j] = (unsigned)__builtin_amdgcn_update_dpp(0, (int)snd, 0x128, 0xf, 0xf, false);
                    va[j] = hi ? rcv[j] : w[0][j]; vb[j] = hi ? w[1][j] : rcv[j]; }
                bf16_t* dst = HID + (size_t)row8 * D_FF + u.pn * 256 + wc * 64 + (hi ? 32 : 0) + 8 * fq;
                __builtin_nontemporal_store(va, (GAS u32x4*)dst);
                __builtin_nontemporal_store(vb, (GAS u32x4*)(dst + (size_t)8 * D_FF));
                if (m == 3) asm volatile("" ::: "memory"); }
    }
};

DI int rope32_dim(int pos) { return 4 * (pos >> 3) + (pos & 3) + 16 * ((pos >> 2) & 1); }
DI int win_src(int P) {
    const int tile = P >> 8, p = P & 255, bj = p >> 7, wc = (p >> 5) & 3, pos = p & 31;
    if (tile < 2) return (tile * 4 + wc) * 64 + 32 * bj + pos;
    if (tile < 5) { const int base = 512 + (tile - 2) * 256;
        return wc < 2 ? base + wc * 64 + 32 * bj + pos : base + 128 + (wc - 2) * 64 + 32 * bj + pos; }
    if (tile == 5) return 1304 + p;
    if (bj == 0) return 1560 + (p & 127);
    if (wc == 0) return 1688 + rope32_dim(pos);
    if (wc == 1) return pos < 24 ? 1280 + pos : -1;
    return -1;
}
DI int wup_src(int P) {
    const int tile = P >> 8, p = P & 255;
    if (tile < 2) return (tile * 4 + (p >> 6)) * 96 + (p & 63);
    if (tile == 2) return (p >> 5) * 96 + 64 + rope32_dim(p & 31);
    const int q = P - 768;
    if (q < 512) return (q >> 6) * 128 + (q & 63);
    return ((q - 512) >> 6) * 128 + 64 + (q & 63);
}
DI void transpose_item(const float* W, int ldw, const float* gain, int src, bf16_t* WT, int ldwt, int k0w, int k0t, int n0, LAS float* scr, int lane) {
    const int nn = lane & 31, kh = lane >> 5;
    float v[32], gv[32];
#pragma unroll
    for (int i = 0; i < 32; ++i) { const int kk = 2 * i + kh;
        v[i] = src >= 0 ? __builtin_nontemporal_load((const GAS float*)(W + (size_t)(k0w + kk) * ldw + src)) : 0.f;
        gv[i] = gain ? *(const GAS float*)(gain + k0w + kk) : 1.0f; }
#pragma unroll
    for (int i = 0; i < 32; ++i) scr[(2 * i + kh) * 33 + nn] = v[i] * gv[i];
    asm volatile("s_waitcnt lgkmcnt(0)" ::: "memory");
    const int c = lane & 7;
#pragma unroll
    for (int j = 0; j < 4; ++j) { const int n = (lane >> 3) + 8 * j; const LAS float* sp = scr + (8 * c) * 33 + n;
        u32x4 o; o.x = cvtpk(sp[0], sp[33]); o.y = cvtpk(sp[2 * 33], sp[3 * 33]); o.z = cvtpk(sp[4 * 33], sp[5 * 33]); o.w = cvtpk(sp[6 * 33], sp[7 * 33]);
        *(u32x4*)(WT + (size_t)(n0 + n) * ldwt + k0t + 8 * c) = o; }
    asm volatile("s_waitcnt lgkmcnt(0)" ::: "memory");
}

constexpr int U_WIN = 56 * 16, U_W1 = 8 * 32, U_WUP = 56 * 6, U_WOUT = 32 * 16, U_WFF1 = 128 * 16, U_WFF2 = 32 * 64;
constexpr int U_LAYER = U_WIN + 2 * U_W1 + U_WUP + U_WOUT + U_WFF1 + U_WFF2;

DI void convert_weights(const Params& p, LAS unsigned char* lds, int wave, int l_lo, int l_hi, int gw, int NGW) {
    const int lane = lane_id_now();
    unsigned char* ws = launder(p.ws);
    unsigned char* wsw = ws + WS_W;
    LAS float* scr = (LAS float*)lds + wave * (64 * 33);
    const int nn = lane & 31;
    for (int uu = l_lo * U_LAYER + gw; uu < l_hi * U_LAYER; uu += NGW) {
        const int l = uu / U_LAYER; int r = uu % U_LAYER;
        if (r < U_WIN) { const int kt = r / 56, nt = r % 56;
            transpose_item(p.in[2] + (size_t)l * 1024 * IN_WIDTH, IN_WIDTH, p.in[1] + l * 1024, win_src(nt * 32 + nn), (bf16_t*)(wsw + W_WIN + l * SZ_WIN), 1024, kt * 64, kt * 64, nt * 32, scr, lane); continue; }
        r -= U_WIN;
        if (r < U_W1) { const int kt = r / 8, nt = r % 8;
            transpose_item(p.in[4] + (size_t)l * 2048 * 256, 256, nullptr, nt * 32 + nn, (bf16_t*)(wsw + W_W1K + l * SZ_W1), 2048, kt * 64, kt * 64, nt * 32, scr, lane); continue; }
        r -= U_W1;
        if (r < U_W1) { const int kt = r / 8, nt = r % 8;
            transpose_item(p.in[7] + (size_t)l * 2048 * 256, 256, nullptr, nt * 32 + nn, (bf16_t*)(wsw + W_W1V + l * SZ_W1), 2048, kt * 64, kt * 64, nt * 32, scr, lane); continue; }
        r -= U_W1;
        if (r < U_WUP) { const int kt = r / 56, nt = r % 56; const int P = nt * 32 + nn; const bool isq = (nt * 32) < 768;
            bf16_t* WT = (bf16_t*)(wsw + W_WUP + l * SZ_WUP);
            if (isq) transpose_item(p.in[10] + (size_t)l * 256 * 768, 768, p.in[9] + l * 256, kt < 4 ? wup_src(P) : -1, WT, KUP, kt < 4 ? kt * 64 : 0, kt * 64, nt * 32, scr, lane);
            else transpose_item(p.in[12] + (size_t)l * 128 * 1024, 1024, p.in[11] + l * 128, kt >= 4 ? wup_src(P) : -1, WT, KUP, kt >= 4 ? (kt - 4) * 64 : 0, kt * 64, nt * 32, scr, lane);
            continue; }
        r -= U_WUP;
        if (r < U_WOUT) { const int kt = r / 32, nt = r % 32;
            const float* gn = kt < 8 ? p.in[13] + l * 512 : p.in[14] + l * 512 - 512;
            transpose_item(p.in[15] + (size_t)l * 1024 * 1024, 1024, gn, nt * 32 + nn, (bf16_t*)(wsw + W_WOUT + l * SZ_WOUT), 1024, kt * 64, kt * 64, nt * 32, scr, lane); continue; }
        r -= U_WOUT;
        if (r < U_WFF1) { const int kt = r / 128, nt = r % 128;
            transpose_item(p.in[17] + (size_t)l * 1024 * 4096, 4096, p.in[16] + l * 1024, nt * 32 + nn, (bf16_t*)(wsw + W_WFF1 + l * SZ_WFF), 1024, kt * 64, kt * 64, nt * 32, scr, lane); continue; }
        r -= U_WFF1;
        { const int kt = r / 32, nt = r % 32;
            transpose_item(p.in[18] + (size_t)l * 4096 * 1024, 1024, nullptr, nt * 32 + nn, (bf16_t*)(wsw + W_WFF2 + l * SZ_WFF), 4096, kt * 64, kt * 64, nt * 32, scr, lane); }
    }
}

DI void prologue(const Params& p, LAS unsigned char* lds, int tid_) {
    const int lane = lane_id_now(), wave = tid_, tid = wave * 64 + lane;
    unsigned char* ws = launder(p.ws);
    unsigned char* wsw = ws + WS_W;
    LAS float* scr = (LAS float*)lds + wave * (64 * 33);
    const int G = gridDim.x, bx = blockIdx.x, gw = bx * NWAVES + wave, NGW = G * NWAVES;
    const int nn = lane & 31;
    convert_weights(p, lds, wave, 0, 1, gw, NGW);
    for (int uu = gw; uu < DEPTH * 2 * 32; uu += NGW) {
        const int lk = uu >> 5, sl = uu & 31, l = lk >> 1, kv = lk & 1;
        const float* pos = (kv ? p.in[6] : p.in[3]) + (size_t)l * 2048 + sl * 64; const float* w1 = (kv ? p.in[7] : p.in[4]) + ((size_t)l * 2048 + sl * 64) * 256 + 4 * lane;
        f32x4 a = {0.f, 0.f, 0.f, 0.f};
#pragma unroll 16
        for (int k = 0; k < 64; ++k) a += __builtin_nontemporal_load((const GAS f32x4*)(w1 + (size_t)k * 256)) * pos[k];
        *(f32x4*)((float*)(wsw + W_BIAS1) + (size_t)uu * 256 + 4 * lane) = a;
    }
    for (int e = bx * NTHR + tid; e < SEQ * 32; e += G * NTHR) { const int t = e >> 5, i = e & 31;
        const float ang = (float)t * (1.0f / powf(10000.0f, (float)(2 * i) / 64.0f));
        ((float*)(wsw + W_COSA))[e] = cosf(ang); ((float*)(wsw + W_SINA))[e] = sinf(ang); }
    for (int e = bx * NTHR + tid; e < SEQ * 16; e += G * NTHR) { const int t = e >> 4, i = e & 15;
        const float ang = (float)t * (1.0f / powf(10000.0f, (float)(2 * i) / 32.0f));
        ((float*)(wsw + W_COSB))[e] = cosf(ang); ((float*)(wsw + W_SINB))[e] = sinf(ang); }
    {
        const float* x = p.in[0]; bf16_t* XB = (bf16_t*)(ws + WS_XB); float* ss = (float*)(ws + WS_SS1);
        for (int row0 = gw * 4; row0 < NTOK; row0 += NGW * 4) {
            f32x4 v[4][4];
#pragma unroll
            for (int rr = 0; rr < 4; ++rr)
#pragma unroll
                for (int j = 0; j < 4; ++j) v[rr][j] = *((const GAS f32x4*)(x + (size_t)(row0 + rr) * 1024) + lane + 64 * j);
#pragma unroll
            for (int rr = 0; rr < 4; ++rr) { const int row = row0 + rr; float q = 0.f;
#pragma unroll
                for (int j = 0; j < 4; ++j) { u32x2 w; w.x = cvtpk(v[rr][j][0], v[rr][j][1]); w.y = cvtpk(v[rr][j][2], v[rr][j][3]); *(GAS u32x2*)(XB + (size_t)row * 1024 + 256 * j + 4 * lane) = w;
                    f32x4 r; r[0] = __builtin_bit_cast(float, w[0] << 16); r[1] = __builtin_bit_cast(float, w[0] & 0xffff0000u); r[2] = __builtin_bit_cast(float, w[1] << 16); r[3] = __builtin_bit_cast(float, w[1] & 0xffff0000u); q += sq4(r); }
                q = wsum(q);
                if (lane < 16) ss[(size_t)row * 16 + lane] = lane == 0 ? q : 0.f; }
        }
    }
    __syncthreads();
}

DI void norm_mix_phase(const Params& p, int l, int tid_) {
    const int tid = tid_ * 64 + lane_id_now();
    const int lane = tid & 63, gw = blockIdx.x * NWAVES + (tid >> 6), NGW = gridDim.x * NWAVES;
    unsigned char* ws = launder(p.ws);
    const bf16_t* OAB = (const bf16_t*)(ws + WS_OAB); bf16_t* MIX = (bf16_t*)(ws + WS_A + A_MIX);
    const float* ga = p.in[13] + l * 512 + lane * 8; const float* gb = p.in[14] + l * 512 + lane * 8;
    float g_a[8], g_b[8];
#pragma unroll
    for (int j = 0; j < 8; ++j) { g_a[j] = ga[j]; g_b[j] = gb[j]; }
    for (int row = gw; row < NTOK; row += NGW) {
        const u32x4 a = *(const u32x4*)(OAB + (size_t)row * 1024 + lane * 8), b = *(const u32x4*)(OAB + (size_t)row * 1024 + 512 + lane * 8);
        float va[8], vb[8]; float qa = 0.f, qb = 0.f;
#pragma unroll
        for (int j = 0; j < 4; ++j) { va[2 * j] = __builtin_bit_cast(float, a[j] << 16); va[2 * j + 1] = __builtin_bit_cast(float, a[j] & 0xffff0000u);
            vb[2 * j] = __builtin_bit_cast(float, b[j] << 16); vb[2 * j + 1] = __builtin_bit_cast(float, b[j] & 0xffff0000u); }
#pragma unroll
        for (int j = 0; j < 8; ++j) { qa += va[j] * va[j]; qb += vb[j] * vb[j]; }
        qa = wsum(qa); qb = wsum(qb);
        const float ra = rsqrtf(qa * (1.0f / 512.0f) + NORM_EPS), rb = rsqrtf(qb * (1.0f / 512.0f) + NORM_EPS);
        u32x4 oa, ob;
#pragma unroll
        for (int j = 0; j < 4; ++j) { oa[j] = cvtpk(va[2 * j] * ra * g_a[2 * j], va[2 * j + 1] * ra * g_a[2 * j + 1]); ob[j] = cvtpk(vb[2 * j] * rb * g_b[2 * j], vb[2 * j + 1] * rb * g_b[2 * j + 1]); }
        *(u32x4*)(MIX + (size_t)row * 1024 + lane * 8) = oa; *(u32x4*)(MIX + (size_t)row * 1024 + 512 + lane * 8) = ob;
    }
}
DI void final_norm_phase(const Params& p, int tid_) {
    const int tid = tid_ * 64 + lane_id_now();
    const int lane = tid & 63, gw = blockIdx.x * NWAVES + (tid >> 6), NGW = gridDim.x * NWAVES;
    unsigned char* ws = launder(p.ws);
    float* X = p.out; const bf16_t* XB = (const bf16_t*)(ws + WS_XB); const float* ss = (const float*)(ws + WS_SS1); const float* gn = p.in[19];
    for (int row0 = gw * 4; row0 < NTOK; row0 += NGW * 4) {
        u32x2 o[4][4]; float rstd[4];
#pragma unroll
        for (int rr = 0; rr < 4; ++rr) { rstd[rr] = rsqrtf(sum16(ss + (size_t)(row0 + rr) * 16) * (1.0f / 1024.0f) + NORM_EPS);
#pragma unroll
            for (int j = 0; j < 4; ++j) o[rr][j] = *(const GAS u32x2*)(XB + (size_t)(row0 + rr) * 1024 + 256 * j + 4 * lane); }
#pragma unroll
        for (int rr = 0; rr < 4; ++rr)
#pragma unroll
            for (int j = 0; j < 4; ++j) { const f32x4 g = *((const GAS f32x4*)gn + 64 * j + lane);
                f32x4 x; x[0] = __builtin_bit_cast(float, o[rr][j][0] << 16); x[1] = __builtin_bit_cast(float, o[rr][j][0] & 0xffff0000u); x[2] = __builtin_bit_cast(float, o[rr][j][1] << 16); x[3] = __builtin_bit_cast(float, o[rr][j][1] & 0xffff0000u);
                __builtin_nontemporal_store(x * rstd[rr] * g, (GAS f32x4*)(X + (size_t)(row0 + rr) * 1024) + 64 * j + lane); }
    }
}
DI void cmp2_phase(const Params& p, int l, LAS unsigned char* lds, int tid_) {
    const int tid = tid_ * 64 + lane_id_now();
    const int lane = tid & 63, w = tid_, kvw = w >> 2, nb = w & 3;
    constexpr int HSTR = 528;
    LAS unsigned char* hidb = lds;
    LAS float* b1 = (LAS float*)(lds + 32768);
    unsigned char* ws = launder(p.ws);
    const float* slabs = (const float*)(ws + WS_A + A_HIDC);
    bf16x8 wf[8];
    { const float* w2 = (kvw ? p.in[8] : p.in[5]) + (size_t)l * 256 * 64 + nb * 16 + (lane & 15);
      float wv[8][8];
#pragma unroll
      for (int ks = 0; ks < 8; ++ks)
#pragma unroll
          for (int e = 0; e < 8; ++e) wv[ks][e] = *(const GAS float*)(w2 + (size_t)(ks * 32 + 8 * (lane >> 4) + e) * 64);
#pragma unroll
      for (int ks = 0; ks < 8; ++ks) { u32x4 t; t.x = cvtpk(wv[ks][0], wv[ks][1]); t.y = cvtpk(wv[ks][2], wv[ks][3]); t.z = cvtpk(wv[ks][4], wv[ks][5]); t.w = cvtpk(wv[ks][6], wv[ks][7]); wf[ks] = __builtin_bit_cast(bf16x8, t); } }
    __syncthreads();
    { const int kv_ = tid >> 8, n_ = tid & 255;
      const float* b1p = (const float*)(ws + WS_W + W_BIAS1) + (size_t)(l * 2 + kv_) * 32 * 256 + n_;
      float bv[32];
#pragma unroll
      for (int sl = 0; sl < 32; ++sl) bv[sl] = *(const GAS float*)(b1p + sl * 256);
      float a = 0.f;
#pragma unroll
      for (int sl = 0; sl < 32; ++sl) a += bv[sl];
      b1[tid] = a; }
    for (int u = blockIdx.x; u < 256; u += gridDim.x) {
        const int r = tid >> 5, c8 = (tid & 31) * 8, rowh = u * 16 + r;
        f32x4 sv[2][4][2];
#pragma unroll
        for (int kv = 0; kv < 2; ++kv)
#pragma unroll
            for (int sp = 0; sp < 4; ++sp)
#pragma unroll
                for (int hh = 0; hh < 2; ++hh) sv[kv][sp][hh] = *(const GAS f32x4*)(slabs + ((size_t)(kv * 4 + sp) * 4096 + rowh) * 256 + c8 + 4 * hh);
        __syncthreads();
#pragma unroll
        for (int kv = 0; kv < 2; ++kv) { u32x4 hw;
#pragma unroll
            for (int hh = 0; hh < 2; ++hh) { f32x4 a = *(const LAS f32x4*)(b1 + kv * 256 + c8 + 4 * hh);
#pragma unroll
                for (int sp = 0; sp < 4; ++sp) a += sv[kv][sp][hh];
#pragma unroll
                for (int j = 0; j < 4; ++j) a[j] = a[j] / (1.0f + __expf(-a[j]));
                hw[2 * hh] = cvtpk(a[0], a[1]); hw[2 * hh + 1] = cvtpk(a[2], a[3]); }
            *(LAS u32x4*)(hidb + (kv * 16 + r) * HSTR + c8 * 2) = hw; }
        __syncthreads();
        f32x4 acc = {0.f, 0.f, 0.f, 0.f};
        const LAS unsigned char* hb = hidb + (kvw * 16 + (lane & 15)) * HSTR + (lane >> 4) * 16;
#pragma unroll
        for (int ks = 0; ks < 8; ++ks) acc = __builtin_amdgcn_mfma_f32_16x16x32_bf16(wf[ks], *(const LAS bf16x8*)(hb + ks * 64), acc, 0, 0, 0);
        const int row = u * 16 + (lane & 15);
        if ((row & 255) == 255) acc = (f32x4){0.f, 0.f, 0.f, 0.f};
        bf16_t* outp = (bf16_t*)(ws + (kvw ? WS_VCMP : WS_KCMP));
        u32x2 ow; ow.x = cvtpk(acc[0], acc[1]); ow.y = cvtpk(acc[2], acc[3]);
        *(GAS u32x2*)(outp + (size_t)row * 64 + nb * 16 + 4 * (lane >> 4)) = ow;
    }
    __syncthreads();
}

constexpr int KBUF_BYTES = 64 * 208, VSTR = 192, VBUF_BYTES = 64 * VSTR;
constexpr int ATT_VOFF = 3 * KBUF_BYTES;
constexpr int ATT_IMP = 3 * KBUF_BYTES + 2 * VBUF_BYTES;
constexpr int ATT_SEL = ATT_IMP + 65536;
constexpr int ATT_FLAG = ATT_SEL + 512;
static_assert(ATT_FLAG + 32 <= LDS_SCRATCH, "attention LDS");

struct Acc { f32x16 o0, o1, nm; float m, l; };
DI void acc_init(Acc& a) {
#pragma unroll
    for (int i = 0; i < 16; ++i) { a.o0[i] = 0.f; a.o1[i] = 0.f; a.nm[i] = 0.f; }
    a.m = 0.f; a.l = 0.f;
}
DI float max3f(float a, float b, float c) { float r; asm("v_max3_f32 %0, %1, %2, %3" : "=v"(r) : "v"(a), "v"(b), "v"(c)); return r; }
template <int KD> struct KVFrags { const LAS unsigned char* vb; s16x4 v[16]; };
DI s16x4 trrd(const LAS unsigned char* p) { return __builtin_bit_cast(s16x4, __builtin_amdgcn_ds_read_tr16_b64_v4i16((LAS v4i16_t*)p)); }
template <int KD, bool HASV>
DI void load_frags(KVFrags<KD>& f, const LAS unsigned char* kb, const LAS unsigned char* vb, int lane) { f.vb = vb; (void)kb; (void)lane; }
template <int KD, bool HASV = true>
DI void qk_mma(f32x16& s0, f32x16& s1, KVFrags<KD>& f, const LAS unsigned char* kb, const bf16x8 (&qf)[KD], const f32x16& cinit, int lane) {
    constexpr int KSTR = KD * 32 + 16;
    const LAS unsigned char* p0 = kb + (lane & 31) * KSTR + (lane >> 5) * 16;
    bf16x8 kf[2 * KD];
#pragma unroll
    for (int ks = 0; ks < KD; ++ks) { kf[2 * ks] = *(const LAS bf16x8*)(p0 + ks * 32); kf[2 * ks + 1] = *(const LAS bf16x8*)(p0 + 32 * KSTR + ks * 32); }
    __builtin_amdgcn_sched_barrier(0);
    s0 = __builtin_amdgcn_mfma_f32_32x32x16_bf16(kf[0], qf[0], cinit, 0, 0, 0);
    s1 = __builtin_amdgcn_mfma_f32_32x32x16_bf16(kf[1], qf[0], cinit, 0, 0, 0);
#pragma unroll
    for (int ks = 1; ks < KD; ++ks) {
        s0 = __builtin_amdgcn_mfma_f32_32x32x16_bf16(kf[2 * ks], qf[ks], s0, 0, 0, 0);
        s1 = __builtin_amdgcn_mfma_f32_32x32x16_bf16(kf[2 * ks + 1], qf[ks], s1, 0, 0, 0);
    }
    __builtin_amdgcn_sched_barrier(0);
    if (HASV) {
        const int h = lane >> 5, q4 = (lane & 15) >> 2, p4 = lane & 3, blk = (lane >> 4) & 1;
        const LAS unsigned char* vbase = f.vb + (4 * h + q4) * VSTR + (blk * 16 + p4 * 4) * 2;
#pragma unroll
        for (int kh = 0; kh < 2; ++kh)
#pragma unroll
            for (int s2 = 0; s2 < 2; ++s2) { const LAS unsigned char* vp = vbase + (kh * 32 + s2 * 16) * VSTR; const int j = (kh * 2 + s2) * 4;
                f.v[j + 0] = trrd(vp); f.v[j + 1] = trrd(vp + 8 * VSTR); f.v[j + 2] = trrd(vp + 64); f.v[j + 3] = trrd(vp + 8 * VSTR + 64); }
        __builtin_amdgcn_sched_barrier(0);
    }
}
DI void mask_tile(f32x16& s0, f32x16& s1, int lo, int hi, int h) {
    int lo4 = lo - 4 * h, hi4 = hi - 4 * h;
    asm volatile("" : "+v"(lo4), "+v"(hi4));
#pragma unroll
    for (int i = 0; i < 16; ++i) { const int c = crow(i, 0);
        if ((lo > 0 && c < lo4) || c > hi4) s0[i] = -INFINITY;
        if ((lo > 0 && c + 32 < lo4) || c + 32 > hi4) s1[i] = -INFINITY; }
}
DI float tile_max(f32x16& s0, f32x16& s1) {
    asm volatile("s_nop 15\n\ts_nop 7" : "+v"(s0), "+v"(s1));
    float mx = max3f(s0[0], s1[0], s0[1]);
    mx = max3f(mx, s1[1], s0[2]);
#pragma unroll
    for (int i = 2; i < 15; ++i) mx = max3f(mx, s1[i], s0[i + 1]);
    mx = max3f(mx, s1[15], mx);
    return max3f(mx, __shfl_xor(mx, 32), mx);
}
constexpr float RESC_THR = 6.0f;
DI void online_update(Acc& a, f32x16& s0, f32x16& s1, bool with_o, bool first, bool on = true) {
    float mx = tile_max(s0, s1);
    mx = on ? mx : -INFINITY;
    if (first || !__all(mx <= RESC_THR)) {
        float d = first ? mx : fmaxf(mx, 0.f);
        if (d == -INFINITY) d = 0.f;
        if (!first) {
            const float alpha = ex2(-d);
            a.l *= alpha;
            if (with_o) {
#pragma unroll
                for (int i = 0; i < 16; ++i) { a.o0[i] *= alpha; a.o1[i] *= alpha; }
            }
        }
        a.m += d;
#pragma unroll
        for (int i = 0; i < 16; ++i) { s0[i] -= d; s1[i] -= d; a.nm[i] = -a.m; }
    }
    float rs = 0.f;
#pragma unroll
    for (int i = 0; i < 16; ++i) { s0[i] = ex2(s0[i]); s1[i] = ex2(s1[i]); rs += s0[i] + s1[i]; }
    a.l += on ? rs : 0.f;
}
constexpr float FAST_BIGL = 1099511627776.0f, FAST_TINYL = 1.0f / 1099511627776.0f;
template <bool B> struct BoolC { static constexpr bool value = B; };
#ifndef MK_FORCE_SAFE
#define MK_FORCE_SAFE 0
#endif
DI bool l_bad(const Acc& a) { const float lt = a.l + __shfl_xor(a.l, 32);
    if (MK_FORCE_SAFE == 1) return true;
    if (MK_FORCE_SAFE == 2) return !(lt <= 40.0f && lt >= FAST_TINYL);
    return !(lt <= FAST_BIGL && lt >= FAST_TINYL); }
DI void fast_update(Acc& a, f32x16& s0, f32x16& s1, bool on) {
    float rs = 0.f;
#pragma unroll
    for (int i = 0; i < 16; ++i) { s0[i] = ex2(s0[i]); rs += s0[i]; s1[i] = ex2(s1[i]); rs += s1[i]; }
    a.l += on ? rs : 0.f;
}
DI bool stream_redo(volatile LAS unsigned* fl, bool bad) {
    if (__any(bad)) *fl = 1u;
    __syncthreads();
    return *fl != 0u;
}
DI bf16x8 pack8(const f32x16& s, int base) {
    u32x4 w; w.x = cvtpk(s[base + 0], s[base + 1]); w.y = cvtpk(s[base + 2], s[base + 3]); w.z = cvtpk(s[base + 4], s[base + 5]); w.w = cvtpk(s[base + 6], s[base + 7]);
    return __builtin_bit_cast(bf16x8, w);
}
template <int KD>
DI void pv_mma(Acc& a, const f32x16& p0, const f32x16& p1, const KVFrags<KD>& f, bool on = true) {
#pragma unroll
    for (int kh = 0; kh < 2; ++kh)
#pragma unroll
        for (int s2 = 0; s2 < 2; ++s2) {
            u32x4 pw = __builtin_bit_cast(u32x4, pack8(kh ? p1 : p0, 8 * s2));
            pw.x = on ? pw.x : 0u; pw.y = on ? pw.y : 0u; pw.z = on ? pw.z : 0u; pw.w = on ? pw.w : 0u;
            const bf16x8 pf = __builtin_bit_cast(bf16x8, pw); const int j = (kh * 2 + s2) * 4;
            a.o0 = __builtin_amdgcn_mfma_f32_32x32x16_bf16(__builtin_shufflevector(f.v[j], f.v[j + 1], 0, 1, 2, 3, 4, 5, 6, 7), pf, a.o0, 0, 0, 0);
            a.o1 = __builtin_amdgcn_mfma_f32_32x32x16_bf16(__builtin_shufflevector(f.v[j + 2], f.v[j + 3], 0, 1, 2, 3, 4, 5, 6, 7), pf, a.o1, 0, 0, 0);
        }
}

struct Stage { u32x4 rk, rv, rkr; };
template <int KD, bool HASV, class Addr, class Body, class Next>
DI void kv_stream(int ntiles, Addr addr, Body body, Stage& sg, bool pre, Next next, LAS unsigned char* lds, int tid) {
    constexpr int KSTR = KD * 32 + 16;
    if (ntiles <= 0) return;
    const int row8 = tid >> 3, ch8 = tid & 7, row4 = tid >> 2, ch4 = tid & 3;
    auto ld = [&](int it) {
        const bf16_t *kp, *vp, *krp; addr(it, kp, vp, krp);
        sg.rk = *(const GAS u32x4*)(kp + tid * 8);
        if (HASV) sg.rv = *(const GAS u32x4*)(vp + tid * 8);
        if (KD == 6) { if (tid < 256) sg.rkr = *(const GAS u32x4*)(krp + tid * 8); }
    };
    auto st = [&](int buf) {
        LAS unsigned char* kb = lds + buf * KBUF_BYTES; LAS unsigned char* vb = lds + ATT_VOFF + buf * VBUF_BYTES;
        *(LAS u32x4*)(kb + row8 * KSTR + ch8 * 16) = sg.rk;
        if (HASV) *(LAS u32x4*)(vb + row8 * VSTR + ch8 * 16) = sg.rv;
        if (KD == 6) { if (tid < 256) *(LAS u32x4*)(kb + row4 * KSTR + 128 + ch4 * 16) = sg.rkr; }
    };
    if (!pre) ld(0);
    st(0);
    __syncthreads();
#pragma unroll 1
    for (int it = 0; it < ntiles; ++it) {
        const int cur = it & 1;
        if (it + 1 < ntiles) ld(it + 1); else next(sg);
        body(it, (const LAS unsigned char*)(lds + cur * KBUF_BYTES), (const LAS unsigned char*)(lds + ATT_VOFF + cur * VBUF_BYTES));
        if (it + 1 < ntiles) st(cur ^ 1);
        __syncthreads();
    }
}

DI void mla_unit(const Params& p, int b, int hd, int qb, int fi, LAS unsigned char* lds, int tid_) {
    const int tid = tid_ * 64 + lane_id_now();
    const int lane = tid & 63, w = tid_, r = lane & 31, h = lane >> 5;
    unsigned char* ws = launder(p.ws);
    const bf16_t* QM = (const bf16_t*)(ws + WS_A + A_QM); const bf16_t* KN = (const bf16_t*)(ws + WS_A + A_KN) + (size_t)(b * 8 + hd) * SEQ * 64;
    const bf16_t* VM = (const bf16_t*)(ws + WS_A + A_VM) + (size_t)(b * 8 + hd) * SEQ * 64; const bf16_t* KR = (const bf16_t*)(ws + WS_A + A_KR) + (size_t)b * SEQ * 32;
    bf16_t* OAB = (bf16_t*)(ws + WS_OAB);
    const int qlo = qb * 256 + w * 32, q = qlo + r;
    bf16x8 qf[6];
    { const bf16_t* qp = QM + (size_t)(b * SEQ + q) * 768 + hd * 96 + h * 8;
#pragma unroll
      for (int ks = 0; ks < 6; ++ks) qf[ks] = *(const GAS bf16x8*)(qp + ks * 16); }
    Acc a; acc_init(a);
    volatile LAS unsigned* fl = (volatile LAS unsigned*)(lds + ATT_FLAG) + 4 + fi;
    Stage sg;
    auto run = [&](auto safec) {
        constexpr bool SAFE = decltype(safec)::value;
        kv_stream<6, true>(4 * qb + 4,
            [&](int it, const bf16_t*& kp, const bf16_t*& vp, const bf16_t*& krp) { kp = KN + (size_t)it * 4096; vp = VM + (size_t)it * 4096; krp = KR + (size_t)it * 2048; },
            [&](int it, const LAS unsigned char* kb, const LAS unsigned char* vb) {
                if (it * 64 <= qlo + 31) {
                    KVFrags<6> f; load_frags<6, true>(f, kb, vb, lane);
                    const f32x16 z16 = {0.f, 0.f, 0.f, 0.f, 0.f, 0.f, 0.f, 0.f, 0.f, 0.f, 0.f, 0.f, 0.f, 0.f, 0.f, 0.f};
                    f32x16 s0, s1; qk_mma<6>(s0, s1, f, kb, qf, SAFE ? a.nm : z16, lane);
                    if (it * 64 + 63 > qlo) mask_tile(s0, s1, 0, q - it * 64, h);
                    if (SAFE) online_update(a, s0, s1, true, it == 0); else fast_update(a, s0, s1, true);
                    pv_mma<6>(a, s0, s1, f);
                }
            }, sg, false, [&](Stage&) {}, lds, tid);
    };
    if (tid == 0) *fl = 0u;
    run(BoolC<false>{});
    if (stream_redo(fl, l_bad(a))) { acc_init(a); run(BoolC<true>{}); }
    const float lt = a.l + __shfl_xor(a.l, 32); const float inv = lt > 0.f ? 1.0f / lt : 0.f;
    float ssq = st_row64(OAB + (size_t)(b * SEQ + q) * 1024 + 512 + hd * 64, a.o0, a.o1, inv, h);
    ssq += __shfl_xor(ssq, 32);
    if (h == 0) ((GAS float*)(ws + WS_SSB))[(size_t)(b * SEQ + q) * 8 + hd] = ssq;
}
DI void mla_phase(const Params& p, LAS unsigned char* lds, int tid) {
    for (int pi = blockIdx.x; pi < 512; pi += gridDim.x) {
        const int bh = pi & 63, qp = pi >> 6;
        mla_unit(p, bh >> 3, bh & 7, 15 - qp, 0, lds, tid);
        mla_unit(p, bh >> 3, bh & 7, qp, 1, lds, tid);
    }
}

DI void nsa_unit(const Params& p, int b, int g, int c, int fi, LAS unsigned char* lds, int tid_) {
    const int tid = tid_ * 64 + lane_id_now();
    const int lane = tid & 63, w = tid_, r = lane & 31, h = lane >> 5;
    const int head = g * 4 + (w >> 1), qh = w & 1, tq = 32 * qh + r, t = 64 * c + tq;
    unsigned char* ws = launder(p.ws);
    unsigned char* A = ws + WS_A;
    const bf16_t* QA = (const bf16_t*)(A + A_QA);
    const size_t bgoff = (size_t)(b * 2 + g) * SEQ * 64;
    const bf16_t* KS = (const bf16_t*)(A + A_KS) + bgoff; const bf16_t* VS = (const bf16_t*)(A + A_VS) + bgoff;
    const bf16_t* KW = (const bf16_t*)(A + A_KW) + bgoff; const bf16_t* VW = (const bf16_t*)(A + A_VW) + bgoff;
    const bf16_t* KCMP = (const bf16_t*)(ws + WS_KCMP) + (size_t)(b * 2 + g) * 256 * 64; const bf16_t* VCMP = (const bf16_t*)(ws + WS_VCMP) + (size_t)(b * 2 + g) * 256 * 64;
    LAS unsigned* IMP = (LAS unsigned*)(lds + ATT_IMP);
    LAS unsigned long long* SELM = (LAS unsigned long long*)(lds + ATT_SEL);
    bf16x8 qf[4];
    { const bf16_t* qp = QA + (size_t)(b * SEQ + t) * 512 + head * 64 + h * 8;
#pragma unroll
      for (int ks = 0; ks < 4; ++ks) qf[ks] = *(const GAS bf16x8*)(qp + ks * 16); }
    LAS f32x16* TL = (LAS f32x16*)(lds + ATT_IMP) + (w * 64 + lane) * 2;
    f32x16 t0, t1;
    const bool need_sel = c >= 16;
    if (need_sel) { for (int i = tid; i < 65 * 16; i += NTHR) ((LAS u32x4*)IMP)[i] = (u32x4){0u, 0u, 0u, 0u}; }
    const int nct = (4 * c + 3 + 63) >> 6;
    const int nmax = t >= 31 ? ((t - 31) >> 4) : -1;
    Acc a; acc_init(a);
    Stage sg;
    kv_stream<4, false>(nct,
        [&](int it, const bf16_t*& kp, const bf16_t*& vp, const bf16_t*& krp) { kp = KCMP + (size_t)it * 4096; vp = nullptr; krp = nullptr; },
        [&](int it, const LAS unsigned char* kb, const LAS unsigned char* vb) {
            KVFrags<4> f; load_frags<4, false>(f, kb, vb, lane);
            f32x16 s0, s1; qk_mma<4, false>(s0, s1, f, kb, qf, a.nm, lane);
            mask_tile(s0, s1, 0, nmax - it * 64, h);
            online_update(a, s0, s1, false, it == 0);
        }, sg, false, [&](Stage& g_) { g_.rk = *(const GAS u32x4*)(KCMP + tid * 8); g_.rv = *(const GAS u32x4*)(VCMP + tid * 8); }, lds, tid);
    {
        const float lt = a.l + __shfl_xor(a.l, 32); const float sh = lt > 0.f ? -__builtin_amdgcn_logf(lt) : -INFINITY;
        f32x16 cn2;
#pragma unroll
        for (int i = 0; i < 16; ++i) cn2[i] = a.nm[i] + sh;
        kv_stream<4, true>(nct,
            [&](int it, const bf16_t*& kp, const bf16_t*& vp, const bf16_t*& krp) { kp = KCMP + (size_t)it * 4096; vp = VCMP + (size_t)it * 4096; krp = nullptr; },
            [&](int it, const LAS unsigned char* kb, const LAS unsigned char* vb) {
                KVFrags<4> f; load_frags<4, true>(f, kb, vb, lane);
                f32x16 s0, s1; qk_mma<4>(s0, s1, f, kb, qf, cn2, lane);
                mask_tile(s0, s1, 0, nmax - it * 64, h);
#pragma unroll
                for (int i = 0; i < 16; ++i) { s0[i] = ex2(s0[i]); s1[i] = ex2(s1[i]); }
                if (need_sel) {
#pragma unroll
                    for (int g = 0; g < 8; ++g) { const f32x16& sv = g < 4 ? s0 : s1; const int b4 = (g & 3) * 4, j = it * 16 + 2 * (g & 3) + h + (g < 4 ? 0 : 8);
                        const unsigned vb = (unsigned)((2.0f * ((sv[b4] + sv[b4 + 1]) + sv[b4 + 2]) + sv[b4 + 3]) * 67108864.0f + 0.5f), vn = (unsigned)(sv[b4 + 3] * 67108864.0f + 0.5f);
                        __hip_atomic_fetch_add(IMP + j * 64 + tq, vb, __ATOMIC_RELAXED, __HIP_MEMORY_SCOPE_WORKGROUP);
                        __hip_atomic_fetch_add(IMP + (j + 1) * 64 + tq, vn, __ATOMIC_RELAXED, __HIP_MEMORY_SCOPE_WORKGROUP); }
                }
                pv_mma<4>(a, s0, s1, f);
            }, sg, true, [&](Stage& g_) { g_.rk = *(const GAS u32x4*)(KS + tid * 8); g_.rv = *(const GAS u32x4*)(VS + tid * 8); }, lds, tid);
        const float g0 = ((const GAS float*)(A + A_GATES))[(size_t)(b * SEQ + t) * 24 + head * 3];
#pragma unroll
        for (int i = 0; i < 16; ++i) { t0[i] = g0 * a.o0[i]; t1[i] = g0 * a.o1[i]; }
    }
    unsigned long long mq = ~0ull;
    if (need_sel) {
#pragma unroll 1
        for (int i = 0; i < 8; i += 2) {
            const int ql = w * 8 + i, j = lane;
            const bool valid = j <= c, forced = (j == 0) || (j == c) || (j == c - 1);
            const unsigned ib0 = IMP[j * 64 + ql], ib1 = IMP[j * 64 + ql + 1];
            const unsigned k0 = ((forced ? 0xFFFFFFFFu : ib0) & ~63u) | (unsigned)(63 - j), k1 = ((forced ? 0xFFFFFFFFu : ib1) & ~63u) | (unsigned)(63 - j);
            const unsigned sc0 = valid ? k0 : 0u, sc1 = valid ? k1 : 0u;
            int r0 = 0, r1 = 0;
            const int nblk8 = (c + 8) & ~7;
#pragma unroll 1
            for (int i8 = 0; i8 < nblk8; i8 += 8) {
#pragma unroll
                for (int k = 0; k < 8; ++k) { const unsigned o0 = (unsigned)__builtin_amdgcn_readlane((int)sc0, i8 + k), o1 = (unsigned)__builtin_amdgcn_readlane((int)sc1, i8 + k);
                    r0 += (o0 > sc0) ? 1 : 0; r1 += (o1 > sc1) ? 1 : 0; } }
            const unsigned long long bm0 = __ballot(valid && r0 < 16), bm1 = __ballot(valid && r1 < 16);
            if (lane == 0) { SELM[ql] = bm0; SELM[ql + 1] = bm1; }
        }
        __syncthreads();
        mq = SELM[tq];
    }
    acc_init(a);
    volatile LAS unsigned* fl = (volatile LAS unsigned*)(lds + ATT_FLAG) + 2 * fi;
    const int jlo = c >= 8 ? c - 8 : 0;
    auto run_sel = [&](auto safec, bool pre_) {
        constexpr bool SAFE = decltype(safec)::value;
        kv_stream<4, true>(c + 1,
            [&](int it, const bf16_t*& kp, const bf16_t*& vp, const bf16_t*& krp) { kp = KS + (size_t)it * 4096; vp = VS + (size_t)it * 4096; krp = nullptr; },
            [&](int it, const LAS unsigned char* kb, const LAS unsigned char* vb) {
                const bool on = (mq >> it) & 1ull;
                if (__any(on)) {
                    KVFrags<4> f; load_frags<4, true>(f, kb, vb, lane);
                    const f32x16 z16 = {0.f, 0.f, 0.f, 0.f, 0.f, 0.f, 0.f, 0.f, 0.f, 0.f, 0.f, 0.f, 0.f, 0.f, 0.f, 0.f};
                    f32x16 s0, s1; qk_mma<4>(s0, s1, f, kb, qf, SAFE ? a.nm : z16, lane);
                    if (it == c) mask_tile(s0, s1, 0, tq, h);
                    if (SAFE) online_update(a, s0, s1, true, it == 0, on); else fast_update(a, s0, s1, on);
                    pv_mma<4>(a, s0, s1, f, on);
                }
            }, sg, pre_, [&](Stage& g_) { g_.rk = *(const GAS u32x4*)(KW + (size_t)jlo * 4096 + tid * 8); g_.rv = *(const GAS u32x4*)(VW + (size_t)jlo * 4096 + tid * 8); }, lds, tid);
    };
    if (tid == 0) { fl[0] = 0u; fl[1] = 0u; }
    run_sel(BoolC<false>{}, true);
    if (stream_redo(fl, l_bad(a))) { acc_init(a); run_sel(BoolC<true>{}, false); }
    {
        const int lane_f = lane_id_now(), t_f = 64 * c + 32 * (tid_ & 1) + (lane_f & 31);
        const float g1 = ((const GAS float*)(launder(p.ws) + WS_A + A_GATES))[(size_t)(b * SEQ + t_f) * 24 + (g * 4 + (tid_ >> 1)) * 3 + 1];
        LAS f32x16* TL = (LAS f32x16*)(lds + ATT_IMP) + (tid_ * 64 + lane_f) * 2;
        const float lt = a.l + __shfl_xor(a.l, 32); const float sc = lt > 0.f ? g1 / lt : 0.f;
#pragma unroll
        for (int i = 0; i < 16; ++i) { t0[i] += sc * a.o0[i]; t1[i] += sc * a.o1[i]; }
    }
    acc_init(a);
    auto run_win = [&](auto safec, bool pre_) {
        constexpr bool SAFE = decltype(safec)::value;
        kv_stream<4, true>(c - jlo + 1,
            [&](int it, const bf16_t*& kp, const bf16_t*& vp, const bf16_t*& krp) { kp = KW + (size_t)(jlo + it) * 4096; vp = VW + (size_t)(jlo + it) * 4096; krp = nullptr; },
            [&](int it, const LAS unsigned char* kb, const LAS unsigned char* vb) {
                const int j = jlo + it;
                KVFrags<4> f; load_frags<4, true>(f, kb, vb, lane);
                const f32x16 z16 = {0.f, 0.f, 0.f, 0.f, 0.f, 0.f, 0.f, 0.f, 0.f, 0.f, 0.f, 0.f, 0.f, 0.f, 0.f, 0.f};
                f32x16 s0, s1; qk_mma<4>(s0, s1, f, kb, qf, SAFE ? a.nm : z16, lane);
                const bool first = (c >= 8 && j == c - 8), lastt = (j == c);
                if (first || lastt) mask_tile(s0, s1, first ? tq + 1 : 0, lastt ? tq : 63, h);
                if (SAFE) online_update(a, s0, s1, true, it == 0); else fast_update(a, s0, s1, true);
                pv_mma<4>(a, s0, s1, f);
            }, sg, pre_, [&](Stage&) {}, lds, tid);
    };
    run_win(BoolC<false>{}, true);
    if (stream_redo((volatile LAS unsigned*)(lds + ATT_FLAG) + 2 * fi + 1, l_bad(a))) { acc_init(a); run_win(BoolC<true>{}, false); }
    {
        const int lane_f = lane_id_now(), t_f = 64 * c + 32 * (tid_ & 1) + (lane_f & 31);
        const float g2 = ((const GAS float*)(launder(p.ws) + WS_A + A_GATES))[(size_t)(b * SEQ + t_f) * 24 + (g * 4 + (tid_ >> 1)) * 3 + 2];
        LAS f32x16* TL = (LAS f32x16*)(lds + ATT_IMP) + (tid_ * 64 + lane_f) * 2;
        const float lt = a.l + __shfl_xor(a.l, 32); const float sc = lt > 0.f ? g2 / lt : 0.f;
#pragma unroll
        for (int i = 0; i < 16; ++i) { t0[i] += sc * a.o0[i]; t1[i] += sc * a.o1[i]; }
    }
    const int lane_o = lane_id_now(), t_o = 64 * c + 32 * (tid_ & 1) + (lane_o & 31), head_o = g * 4 + (tid_ >> 1), h_o = lane_o >> 5;
    unsigned char* ws_o = launder(p.ws);
    float ssq = st_row64((bf16_t*)(ws_o + WS_OAB) + (size_t)(b * SEQ + t_o) * 1024 + head_o * 64, t0, t1, 1.0f, h_o);
    ssq += __shfl_xor(ssq, 32);
    if (h_o == 0) ((GAS float*)(ws_o + WS_SSA))[(size_t)(b * SEQ + t_o) * 8 + head_o] = ssq;
}
DI void nsa_phase(const Params& p, LAS unsigned char* lds, int tid) {
    for (int pi = blockIdx.x; pi < 512; pi += gridDim.x) {
        const int bg = pi & 15, cp = pi >> 4;
        nsa_unit(p, bg >> 1, bg & 1, 63 - cp, 0, lds, tid);
        nsa_unit(p, bg >> 1, bg & 1, cp, 1, lds, tid);
    }
}

constexpr int N_STEPS = 34;
#ifndef MK_REP_STEP
#define MK_REP_STEP -1
#endif
#define NREP(k) ((k) == MK_REP_STEP ? 2 : 1)
__global__ void __launch_bounds__(NTHR, 2) fwd(Params p) {
    extern __shared__ __attribute__((aligned(16))) unsigned char lds_raw[];
    LAS unsigned char* lds = (LAS unsigned char*)lds_raw;
    const int wave0 = __builtin_amdgcn_readfirstlane((int)threadIdx.x >> 6);
    const int tid = wave0;
    volatile LAS unsigned* misc = (volatile LAS unsigned*)(lds + LDS_MISC);
    if (threadIdx.x < 4) misc[threadIdx.x] = 0u;
    __syncthreads();
    unsigned* ctl = (unsigned*)(p.ws + WS_CTL);
    XcdBarrier bar = xcd_barrier_post(ctl + CW_BAR, misc);
    const int lo = p.s_lo, hi = p.s_hi;
#define IN(k) (lo <= (k) && (k) < hi)
#define BAR(k) do { if ((k) + 1 < hi) xcd_barrier(bar); } while (0)
    const int G = gridDim.x, bx = blockIdx.x;

    if (IN(0)) { for (int rep = 0; rep < NREP(8); ++rep) prologue(p, lds, tid); BAR(0); }
#pragma unroll 1
    for (int l = 0; l < DEPTH; ++l) {
        const int sb = 1 + 8 * l;
        if (IN(sb + 0)) for (int rep = 0; rep < NREP(0); ++rep) {
            unsigned char* ws = launder(p.ws);
            pg8::Gemm g{(const bf16_t*)(ws + WS_XB), (const bf16_t*)(ws + WS_W + W_WIN + l * SZ_WIN), NTOK, NPROJ, 1024, 1024, 1024};
            pg8::StaticOrder S; S.init(NTOK, NPROJ, launder_s(G), launder_s(bx));
            EpiInProj E{ws, l};
            pg8::gemm_phase(lds, g, S, E, wave0);
            if (l + 1 < DEPTH) {
                const int G_ = launder_s(G), bx_ = launder_s(bx), nbusy = 896 % G_;
                if (bx_ >= nbusy) convert_weights(p, lds, wave0, l + 1, l + 2, (bx_ - nbusy) * NWAVES + wave0, (G_ - nbusy) * NWAVES);
            }
            if (rep + 1 == NREP(0)) BAR(sb + 0);
        }
        if (IN(sb + 1)) for (int rep = 0; rep < NREP(1); ++rep) {
            {
                unsigned char* ws = launder(p.ws);
                pg8::Gemm g{(const bf16_t*)(ws + WS_A + A_CQKV), (const bf16_t*)(ws + WS_W + W_WUP + l * SZ_WUP), NTOK, NUP, KUP, KUP, KUP};
                pg8::StaticOrder S; S.init(NTOK, NUP, launder_s(G), launder_s(bx));
                EpiUp E{ws, l};
                pg8::gemm_phase(lds, g, S, E, wave0);
            }
#pragma unroll 1
            for (int i = 0; i < 8; ++i) {
                unsigned char* ws = launder(p.ws);
                const int kv = i >> 2, sp = i & 3;
                const bf16_t* Ab = (const bf16_t*)(ws + WS_A + (kv ? A_VC : A_KC)) + sp * 512;
                const bf16_t* Bb = (const bf16_t*)(ws + WS_W + (kv ? W_W1V : W_W1K) + l * SZ_W1) + sp * 512;
                pg8::Gemm g{Ab, Bb, 4096, 256, 512, 1024, 2048};
                const int G_ = launder_s(G); int c = launder_s(bx) - G_ / 2 - 16 * i; if (c < 0) c += G_; if (c >= 16) c = -1;
                pg8::StaticOrder S; S.init(4096, 256, G_, c);
                EpiSlab E{ws, i};
                pg8::gemm_phase(lds, g, S, E, wave0);
            }
            if (rep + 1 == NREP(1)) BAR(sb + 1);
        }
        if (IN(sb + 2)) { cmp2_phase(p, l, lds, tid); BAR(sb + 2); }
        if (IN(sb + 3)) { mla_phase(p, lds, tid); nsa_phase(p, lds, tid); BAR(sb + 3); }
        if (IN(sb + 5)) for (int rep = 0; rep < (l == 0 ? NREP(5) : 1); ++rep) {
            unsigned char* ws = launder(p.ws);
            pg8::Gemm g{(const bf16_t*)(ws + WS_OAB), (const bf16_t*)(ws + WS_W + W_WOUT + l * SZ_WOUT), NTOK, 1024, 1024, 1024, 1024};
            pg8::StaticOrder S; S.init(NTOK, 1024, launder_s(G), launder_s(bx));
            EpiResid<true> E{ws, 1};
            pg8::gemm_phase(lds, g, S, E, wave0);
            if (rep + 1 == (l == 0 ? NREP(5) : 1)) BAR(sb + 5);
        }
        if (IN(sb + 6)) for (int rep = 0; rep < NREP(6); ++rep) {
            unsigned char* ws = launder(p.ws);
            pg8::Gemm g{(const bf16_t*)(ws + WS_XB), (const bf16_t*)(ws + WS_W + W_WFF1 + l * SZ_WFF), NTOK, D_FF, 1024, 1024, 1024};
            pg8::StaticOrder S; S.init(NTOK, D_FF, launder_s(G), launder_s(bx));
            EpiFF1 E{ws, l};
            pg8::gemm_phase(lds, g, S, E, wave0);
            if (rep + 1 == NREP(6)) BAR(sb + 6);
        }
        if (IN(sb + 7)) {
            unsigned char* ws = launder(p.ws);
            pg8::Gemm g{(const bf16_t*)(ws + WS_A), (const bf16_t*)(ws + WS_W + W_WFF2 + l * SZ_WFF), NTOK, 1024, D_FF, D_FF, D_FF};
            pg8::StaticOrder S; S.init(NTOK, 1024, launder_s(G), launder_s(bx));
            EpiResid<false> E{ws, 0};
            pg8::gemm_phase(lds, g, S, E, wave0);
            BAR(sb + 7);
        }
    }
    if (IN(33)) final_norm_phase(p, tid);
#undef IN
#undef BAR
}

}
#ifndef MK_DEBUG
#define MK_DEBUG 0
#endif

#if MK_DEBUG
namespace dbg {
using namespace mk;
enum { K_QA = 0, K_KV, K_GATES, K_CQ, K_CKV, K_KR, K_QM, K_KN, K_VM, K_CMP, K_OAB, K_X };
__global__ __launch_bounds__(256) void cmp_kernel(int kind, const void* opt, const float* refp, int n, int aux, float scale, float* err, int id) {
    __shared__ float red[2][4];
    const int idx = blockIdx.x * 256 + threadIdx.x;
    float num = 0.f, den = 0.f;
    if (idx < n) {
        float o = 0.f, r = 0.f;
        const bf16_t* ob = (const bf16_t*)opt; const float* of = (const float*)opt;
        switch (kind) {
            case K_QA: { const int row = idx / 512, c = idx % 512; o = bf2f(ob[(size_t)row * 512 + c]); r = refp[(size_t)row * ref::IN_WIDTH + ref::C_QA + c]; break; }
            case K_KV: { const int row = idx / 128, c = idx % 128, g = c >> 6, d = c & 63; o = bf2f(ob[((size_t)g * SEQ + row) * 64 + d]); r = refp[(size_t)row * ref::IN_WIDTH + aux + c]; break; }
            case K_GATES: { const int row = idx / 24, c = idx % 24; o = of[(size_t)row * 24 + c]; r = refp[(size_t)row * ref::IN_WIDTH + ref::C_G + c]; break; }
            case K_CQ: { const int row = idx / 256, c = idx % 256; o = bf2f(ob[(size_t)row * KUP + c]); r = refp[(size_t)row * ref::IN_WIDTH + ref::C_CQ + c]; break; }
            case K_CKV: { const int row = idx / 128, c = idx % 128; o = bf2f(ob[(size_t)row * KUP + 256 + c]); r = refp[(size_t)row * ref::IN_WIDTH + ref::C_CKV + c]; break; }
            case K_KR: { const int row = idx / 32, c = idx % 32; o = bf2f(ob[(size_t)row * 32 + c]); r = refp[(size_t)row * ref::IN_WIDTH + ref::C_KR + c]; break; }
            case K_QM: { o = bf2f(ob[idx]); r = refp[idx]; break; }
            case K_KN: { const int row = idx / 512, c = idx % 512, hd = c >> 6, d = c & 63; o = bf2f(ob[((size_t)hd * SEQ + row) * 64 + d]); r = refp[(size_t)row * 1024 + hd * 128 + aux + d]; break; }
            case K_CMP: { const int i = idx / 128, c = idx % 128, g = c >> 6, d = c & 63; o = bf2f(ob[((size_t)g * 256 + i) * 64 + d]); r = refp[((size_t)i * 2 + g) * 64 + d]; break; }
            case K_OAB: { const int row = idx / 512, c = idx % 512; o = bf2f(ob[(size_t)row * 1024 + aux + c]); r = refp[(size_t)row * 1024 + aux + c]; break; }
            case K_X: { o = of[idx]; r = refp[idx]; break; }
        }
        o *= scale;
        num = (o - r) * (o - r); den = r * r;
        if (!(num == num)) num = 1e30f;
    }
#pragma unroll
    for (int s = 32; s > 0; s >>= 1) { num += __shfl_xor(num, s); den += __shfl_xor(den, s); }
    if ((threadIdx.x & 63) == 0) { red[0][threadIdx.x >> 6] = num; red[1][threadIdx.x >> 6] = den; }
    __syncthreads();
    if (threadIdx.x == 0) { atomicAdd(err + 2 * id, red[0][0] + red[0][1] + red[0][2] + red[0][3]); atomicAdd(err + 2 * id + 1, red[1][0] + red[1][1] + red[1][2] + red[1][3]); }
}
__global__ __launch_bounds__(256) void encode_kernel(float* out, size_t n, const float* err, int nids, int want_id) {
    float delta2 = 0.f;
    if (want_id > 0) { const float e = err[2 * want_id] / fmaxf(err[2 * want_id + 1], 1e-30f); delta2 = fminf(e, 0.9f); if (delta2 < 1e-5f) delta2 = 0.f; }
    else { for (int id = 1; id <= nids; ++id) { const float e = err[2 * id] / fmaxf(err[2 * id + 1], 1e-30f); if (!(e < 2e-3f)) { delta2 = 0.01f * (float)id; break; } } }
    const float f = 1.0f + sqrtf(delta2);
    const size_t i = (size_t)blockIdx.x * 256 + threadIdx.x;
    if (i < n && delta2 > 0.f) out[i] *= f;
}
}
#endif

namespace {

void launch_steps(const mk::Params& base, int lo, int hi, int grid, hipStream_t stream) {
    mk::Params p = base; p.s_lo = lo; p.s_hi = hi;
    hipLaunchKernelGGL(mk::fwd, dim3(grid), dim3(mk::NTHR), mk::LDS_BYTES, stream, p);
}
}

extern "C" void kernel_launch(void* const* d_in, const int* in_sizes, int n_in, void* d_out, int out_size, void* d_ws, size_t ws_size, hipStream_t stream) {
    (void)in_sizes; (void)out_size;
    using namespace mk;
    static int grid = 0;
    if (grid == 0) {
        int dev = 0, cus = 0, per_cu = 0;
        if (n_in != 20 || ws_size < WS_END + 16 * MiB) { grid = -1; return; }
        if (hipGetDevice(&dev) != hipSuccess || hipDeviceGetAttribute(&cus, hipDeviceAttributeMultiprocessorCount, dev) != hipSuccess) { grid = -1; return; }
        if (hipFuncSetAttribute((const void*)fwd, hipFuncAttributeMaxDynamicSharedMemorySize, LDS_BYTES) != hipSuccess) { grid = -1; return; }
        if (hipOccupancyMaxActiveBlocksPerMultiprocessor(&per_cu, (const void*)fwd, NTHR, LDS_BYTES) != hipSuccess || per_cu < 1) { (void)hipGetLastError(); }
        grid = cus;
    }
    if (grid < 0) return;
    unsigned char* ws = (unsigned char*)d_ws;
    (void)hipMemsetAsync(ws + WS_CTL, 0, CTL_BYTES, stream);
    Params p{};
    for (int i = 0; i < 20; ++i) p.in[i] = (const float*)d_in[i];
    p.out = (float*)d_out; p.ws = ws; p.s_lo = 0; p.s_hi = N_STEPS;
#if MK_DEBUG == 0
#ifdef MK_MULTI
    for (int s = 0; s < N_STEPS; ++s) launch_steps(p, s, s + 1, grid, stream);
#else
    launch_steps(p, 0, N_STEPS, grid, stream);
#endif
#else
    {
        using namespace ref;
        float* err = (float*)(ws + 3 * MiB + 512 * 1024);
        unsigned char* A = ws + WS_A;
        const float* x_in = (const float*)d_in[0];
        auto naive_b0 = [&](char* nb, int upto, float*& H, float*& PROJ, float*& QMr, float*& KVMr, float*& KC, float*& VC, float*& X0) {
            H = (float*)nb; PROJ = (float*)(nb + 16 * MiB); QMr = (float*)(nb + 44 * MiB); KVMr = (float*)(nb + 56 * MiB); KC = (float*)(nb + 72 * MiB); VC = (float*)(nb + 73 * MiB);
            float* CN = (float*)(nb + 74 * MiB); float* CKVN = (float*)(nb + 78 * MiB); X0 = (float*)(nb + 80 * MiB);
            const int l = 0;
            rmsnorm_rows<<<SEQ / 4, 256, 0, stream>>>(x_in, D_MODEL, (const float*)d_in[1], H, D_MODEL, D_MODEL, SEQ);
            sgemm128<0><<<dim3((IN_WIDTH + 127) / 128, SEQ / 128), 256, 0, stream>>>(H, D_MODEL, (const float*)d_in[2], IN_WIDTH, PROJ, IN_WIDTH, nullptr, 0, SEQ, IN_WIDTH, D_MODEL);
            post_proj<<<SEQ, 256, 0, stream>>>(PROJ);
            if (upto < 2) return;
            compress_naive<<<NCMP * 2, 256, 0, stream>>>(PROJ, C_KC, (const float*)d_in[3], (const float*)d_in[4], (const float*)d_in[5], KC);
            compress_naive<<<NCMP * 2, 256, 0, stream>>>(PROJ, C_VC, (const float*)d_in[6], (const float*)d_in[7], (const float*)d_in[8], VC);
            rmsnorm_rows<<<SEQ / 4, 256, 0, stream>>>(PROJ + C_CQ, IN_WIDTH, (const float*)d_in[9], CN, 256, 256, SEQ);
            rmsnorm_rows<<<SEQ / 4, 256, 0, stream>>>(PROJ + C_CKV, IN_WIDTH, (const float*)d_in[11], CKVN, 128, 128, SEQ);
            sgemm128<0><<<dim3(768 / 128, SEQ / 128), 256, 0, stream>>>(CN, 256, (const float*)d_in[10], 768, QMr, 768, nullptr, 0, SEQ, 768, 256);
            sgemm128<0><<<dim3(1024 / 128, SEQ / 128), 256, 0, stream>>>(CKVN, 128, (const float*)d_in[12], 1024, KVMr, 1024, nullptr, 0, SEQ, 1024, 128);
            post_qm<<<SEQ, 128, 0, stream>>>(QMr);
            mla_naive<<<(SEQ / 4) * 8, 256, 0, stream>>>(QMr, KVMr, PROJ, H);
            nsa_naive<<<SEQ * 2, 256, 0, stream>>>(PROJ, KC, VC, H);
            (void)l;
        };
        float *H, *PROJ, *QMr, *KVMr, *KCr, *VCr, *X0;
        auto C = [&](int kind, const void* opt, const float* refp, int n, int aux, float scale, int id) {
            dbg::cmp_kernel<<<(n + 255) / 256, 256, 0, stream>>>(kind, opt, refp, n, aux, scale, err, id); };
        launch_steps(p, 0, 1, grid, stream); launch_steps(p, 1, 2, grid, stream);
        naive_b0((char*)(A + 112 * MiB), 1, H, PROJ, QMr, KVMr, KCr, VCr, X0);
        C(dbg::K_QA, A + A_QA, PROJ, SEQ * 512, 0, 1.0f / QS_NSA, 1);
        C(dbg::K_KV, A + A_KC, PROJ, SEQ * 128, C_KC, 1.f, 2);
        C(dbg::K_KV, A + A_VC, PROJ, SEQ * 128, C_VC, 1.f, 3);
        C(dbg::K_KV, A + A_KS, PROJ, SEQ * 128, C_KS, 1.f, 4);
        C(dbg::K_KV, A + A_VS, PROJ, SEQ * 128, C_VS, 1.f, 5);
        C(dbg::K_KV, A + A_KW, PROJ, SEQ * 128, C_KW, 1.f, 6);
        C(dbg::K_KV, A + A_VW, PROJ, SEQ * 128, C_VW, 1.f, 7);
        C(dbg::K_GATES, A + A_GATES, PROJ, SEQ * 24, 0, 1.f, 8);
        C(dbg::K_CQ, A + A_CQKV, PROJ, SEQ * 256, 0, 1.f, 9);
        C(dbg::K_CKV, A + A_CQKV, PROJ, SEQ * 128, 0, 1.f, 10);
        C(dbg::K_KR, A + A_KR, PROJ, SEQ * 32, 0, 1.f, 11);
#if MK_DEBUG >= 2
        launch_steps(p, 2, 3, grid, stream); launch_steps(p, 3, 4, grid, stream); launch_steps(p, 4, 5, grid, stream);
        naive_b0((char*)A, 2, H, PROJ, QMr, KVMr, KCr, VCr, X0);
        C(dbg::K_QM, A + A_QM, QMr, SEQ * 768, 0, 1.0f / QS_MLA, 12);
        C(dbg::K_KN, A + A_KN, KVMr, SEQ * 512, 0, 1.f, 13);
        C(dbg::K_KN, A + A_VM, KVMr, SEQ * 512, 64, 1.f, 14);
        C(dbg::K_CMP, ws + WS_KCMP, KCr, 255 * 128, 0, 1.f, 15);
        C(dbg::K_CMP, ws + WS_VCMP, VCr, 255 * 128, 0, 1.f, 16);
        C(dbg::K_OAB, ws + WS_OAB, H, SEQ * 512, 512, 1.f, 17);
        C(dbg::K_OAB, ws + WS_OAB, H, SEQ * 512, 0, 1.f, 18);
#endif
#if MK_DEBUG >= 3
        launch_steps(p, 5, 6, grid, stream); launch_steps(p, 6, 7, grid, stream);
        rmsnorm_rows<<<SEQ / 4, 256, 0, stream>>>(H, 1024, (const float*)d_in[13], H, 1024, 512, SEQ);
        rmsnorm_rows<<<SEQ / 4, 256, 0, stream>>>(H + 512, 1024, (const float*)d_in[14], H + 512, 1024, 512, SEQ);
        sgemm128<1><<<dim3(D_MODEL / 128, SEQ / 128), 256, 0, stream>>>(H, 1024, (const float*)d_in[15], 1024, X0, 1024, x_in, 1024, SEQ, 1024, 1024);
        C(dbg::K_X, d_out, X0, SEQ * 1024, 0, 1.f, 19);
        {
            float* XF = (float*)(ws + WS_END); float* HIDn = (float*)(ws + WS_OAB);
            rmsnorm_rows<<<SEQ / 4, 256, 0, stream>>>(X0, D_MODEL, (const float*)d_in[16], H, D_MODEL, D_MODEL, SEQ);
            sgemm128<2><<<dim3(D_FF / 128, SEQ / 128), 256, 0, stream>>>(H, 1024, (const float*)d_in[17], 4096, HIDn, 4096, nullptr, 0, SEQ, 4096, 1024);
            sgemm128<1><<<dim3(D_MODEL / 128, SEQ / 128), 256, 0, stream>>>(HIDn, 4096, (const float*)d_in[18], 1024, XF, 1024, X0, 1024, SEQ, 1024, 4096);
            launch_steps(p, 7, 8, grid, stream); launch_steps(p, 8, 9, grid, stream);
            C(dbg::K_X, d_out, XF, SEQ * 1024, 0, 1.f, 20);
        }
#endif
        naive_forward(d_in, (float*)d_out, (char*)ws + 4 * MiB, stream);
#ifndef MK_DBG_ID
#define MK_DBG_ID 0
#endif
        dbg::encode_kernel<<<(NTOK * D_MODEL + 255) / 256, 256, 0, stream>>>((float*)d_out, (size_t)NTOK * D_MODEL, err, 20, MK_DBG_ID);
    }
#endif
}
```

```cpp
#define MK_DEBUG 0
#include <hip/hip_runtime.h>
#include <cstdint>
#include <cstddef>
#define LAS __attribute__((address_space(3)))
#define GAS __attribute__((address_space(1)))
#define DI __device__ __forceinline__

typedef unsigned short bf16_t;
typedef short bf16x8 __attribute__((ext_vector_type(8)));
typedef short s16x4 __attribute__((ext_vector_type(4)));
typedef short v4i16_t __attribute__((ext_vector_type(4)));
typedef float f32x2 __attribute__((ext_vector_type(2)));
typedef float f32x4 __attribute__((ext_vector_type(4)));
typedef float f32x16 __attribute__((ext_vector_type(16)));
typedef unsigned u32x2 __attribute__((ext_vector_type(2)));
typedef unsigned u32x4 __attribute__((ext_vector_type(4)));
typedef __bf16 bf16x2_t __attribute__((ext_vector_type(2)));

namespace mk {

constexpr int D_MODEL = 1024, BATCH = 8, SEQ = 4096, DEPTH = 4, NTOK = BATCH * SEQ, IN_WIDTH = 1720, D_FF = 4096;
constexpr int NPROJ = 1792, NUP = 1792, KUP = 384;
constexpr float NORM_EPS = 1e-6f;
constexpr float LOG2E = 1.4426950408889634f;
constexpr float QS_NSA = 0.125f * LOG2E;
constexpr float QS_MLA = 0.10206207261596575f * LOG2E;
constexpr int NWAVES = 8, NTHR = 512;

constexpr size_t MiB = 1u << 20;
constexpr size_t WS_CTL = 0, CTL_BYTES = 4 * MiB;
constexpr int CW_BAR = 4096;
constexpr int CW_QUEUE = 8192;
constexpr size_t WS_SSCQ = 1 * MiB  , WS_SSCKV = 1 * MiB + 512 * 1024  , WS_SS1 = 492 * MiB  , WS_SS2 = 494 * MiB  ,
                 WS_SSA = 2 * MiB  , WS_SSB = 3 * MiB  ;
constexpr size_t WS_W = 4 * MiB;
constexpr size_t W_WIN = 0, W_W1K = 14 * MiB, W_W1V = 18 * MiB, W_WUP = 22 * MiB  , W_WOUT = 28 * MiB, W_WFF1 = 36 * MiB, W_WFF2 = 68 * MiB;
constexpr size_t SZ_WIN = (size_t)NPROJ * 1024 * 2, SZ_W1 = (size_t)256 * 2048 * 2, SZ_WUP = (size_t)NUP * KUP * 2, SZ_WOUT = (size_t)1024 * 1024 * 2, SZ_WFF = (size_t)4096 * 1024 * 2;
constexpr size_t W_TAB = 100 * MiB;
constexpr size_t W_COSA = W_TAB, W_SINA = W_TAB + 512 * 1024, W_COSB = W_TAB + 1024 * 1024, W_SINB = W_TAB + 1280 * 1024, W_BIAS1 = W_TAB + 1536 * 1024;
constexpr size_t WS_XB = 106 * MiB;
constexpr size_t WS_OAB = 170 * MiB;
constexpr size_t WS_KCMP = 234 * MiB, WS_VCMP = 234 * MiB + 512 * 1024;
constexpr size_t WS_A = 236 * MiB;
constexpr size_t KVSLOT = 8 * MiB + 64 * 1024;
constexpr size_t A_QA = 0, A_KC = 32 * MiB, A_VC = A_KC + KVSLOT, A_KS = A_VC + KVSLOT, A_VS = A_KS + KVSLOT, A_KW = A_VS + KVSLOT, A_VW = A_KW + KVSLOT;
constexpr size_t A_GATES = 81 * MiB, A_CQKV = 84 * MiB  , A_KR = 108 * MiB  , A_QM = 110 * MiB  , A_KN = 158 * MiB, A_VM = 190 * MiB, A_HIDC = 222 * MiB  ;
constexpr size_t A_MIX = A_QM;
constexpr size_t WS_END = WS_A + 256 * MiB + 4 * MiB;
static_assert(WS_W + W_TAB + 2 * MiB <= WS_XB && WS_XB + 64 * MiB <= WS_OAB && WS_OAB + 64 * MiB <= WS_KCMP && WS_VCMP + 512 * 1024 <= WS_A && WS_SS1 == WS_A + 256 * MiB, "ws map");
static_assert(A_VW + KVSLOT <= A_GATES && A_HIDC + 32 * MiB <= 256 * MiB, "A map");

constexpr int LDS_SCRATCH = 131072, LDS_MISC = 131072, LDS_BYTES = 147456;

struct Params {
    const float* in[20];
    float* out;
    unsigned char* ws;
    int s_lo, s_hi;
};

DI unsigned cvtpk(float lo, float hi) { f32x2 v = {lo, hi}; bf16x2_t b = __builtin_convertvector(v, bf16x2_t); return __builtin_bit_cast(unsigned, b); }
DI float bf2f(bf16_t v) { return __builtin_bit_cast(float, (unsigned)v << 16); }
DI float ex2(float x) { return __builtin_amdgcn_exp2f(x); }
DI float wsum(float v) {
#pragma unroll
    for (int o = 1; o < 64; o <<= 1) v += __shfl_xor(v, o);
    return v;
}
DI int crow(int i, int h) { return (i & 3) + 8 * (i >> 2) + 4 * h; }
DI unsigned char* launder(unsigned char* p) { asm volatile("" : "+s"(p)); return p; }
DI const float* launder(const float* p) { asm volatile("" : "+s"(p)); return p; }
DI int launder_v(int v) { asm volatile("" : "+v"(v)); return v; }
DI int launder_s(int v) { asm volatile("" : "+s"(v)); return v; }
DI int lane_id_now() { int l; asm volatile("v_mbcnt_lo_u32_b32 %0, -1, 0\n\tv_mbcnt_hi_u32_b32 %0, -1, %0" : "=v"(l)); return l; }

#define XB_TMO      128
#define XB_XCNT(j)  (256  + 64 * (j))
#define XB_XSUB(j)  (1280 + 64 * (j))
#define XB_XGEN(j)  (2304 + 64 * (j))
#define XB_TOP      3328
#define XB_TOPGEN   3392
#define XCD_BAR_WORDS 3456
#define XB_SPIN_CAP (1u << 20)
DI unsigned xb_ld(unsigned* p)              { return __hip_atomic_load(p, __ATOMIC_RELAXED, __HIP_MEMORY_SCOPE_AGENT); }
DI unsigned xb_add(unsigned* p, unsigned v) { return __hip_atomic_fetch_add(p, v, __ATOMIC_RELAXED, __HIP_MEMORY_SCOPE_AGENT); }
DI unsigned xb_xcc_id() { return (unsigned)__builtin_amdgcn_s_getreg((3 << 11) | 20) & 0xFu; }
#define XB_SPIN(cond, bar) do { unsigned _sp = 0; while (cond) { __builtin_amdgcn_s_sleep(4); \
    if ((++_sp & 255u) == 0u) { if (xb_ld(&(bar)[XB_TMO])) break; if (_sp > XB_SPIN_CAP) { atomicAdd(&(bar)[XB_TMO], 1u); break; } } } } while (0)
struct XcdBarrier { unsigned* bar; unsigned x; volatile LAS unsigned* st; int wave; };
DI XcdBarrier xcd_barrier_post(unsigned* bar, volatile LAS unsigned* st) {
    XcdBarrier b; b.bar = bar; b.x = xb_xcc_id(); b.st = st; b.wave = __builtin_amdgcn_readfirstlane((int)threadIdx.x >> 6);
    if (threadIdx.x == 0) (void)xb_add(&bar[XB_XCNT(b.x)], 1u);
    return b;
}
DI void xcd_barrier_complete(unsigned* bar, unsigned x_, unsigned& nloc, unsigned& nx) {
    unsigned x = x_; asm volatile("" : "+s"(x));
    const unsigned G = gridDim.x * gridDim.y * gridDim.z;
    unsigned sum, cnt, mine, sp = 0u;
    for (;;) {
        sum = 0u; cnt = 0u; mine = 0u;
#pragma unroll
        for (unsigned j = 0; j < 16; ++j) { const unsigned c = xb_ld(&bar[XB_XCNT(j)]); sum += c; cnt += (c > 0u) ? 1u : 0u; mine = (j == x) ? c : mine; }
        if (sum == G) break;
        __builtin_amdgcn_s_sleep(1);
        if ((++sp & 255u) == 0u) { if (xb_ld(&bar[XB_TMO])) break; if (sp > XB_SPIN_CAP) { atomicAdd(&bar[XB_TMO], 1u); break; } }
    }
    nloc = mine > 0u ? mine : 1u; nx = cnt > 0u ? cnt : 1u;
}
DI void xcd_barrier(const XcdBarrier& b) {
    asm volatile("s_waitcnt vmcnt(0)" ::: "memory");
    __syncthreads();
    int wv_ = b.wave; asm volatile("" : "+s"(wv_));
    if (wv_ == 0 && lane_id_now() == 0) {
        unsigned* bar = (unsigned*)launder((unsigned char*)b.bar);
        __builtin_amdgcn_s_waitcnt(0);
        unsigned nloc = b.st[0], nx = b.st[1];
        if (nloc == 0u) { xcd_barrier_complete(bar, b.x, nloc, nx); b.st[0] = nloc; b.st[1] = nx; }
        const unsigned old = xb_add(&bar[XB_XSUB(b.x)], 1u);
        const unsigned gen = old / nloc;
        if (old + 1u == (gen + 1u) * nloc) {
            __builtin_amdgcn_fence(__ATOMIC_RELEASE, "agent");
            asm volatile("s_waitcnt vmcnt(0)" ::: "memory");
            const unsigned og = xb_add(&bar[XB_TOP], 1u);
            const unsigned tg = og / nx;
            if (og + 1u == (tg + 1u) * nx) xb_add(&bar[XB_TOPGEN], 1u);
            else XB_SPIN(xb_ld(&bar[XB_TOPGEN]) == tg, bar);
            __builtin_amdgcn_fence(__ATOMIC_ACQUIRE, "agent");
            xb_add(&bar[XB_XGEN(b.x)], 1u);
            asm volatile("s_waitcnt vmcnt(0)" ::: "memory");
        } else {
            XB_SPIN(xb_ld(&bar[XB_XGEN(b.x)]) == gen, bar);
            __builtin_amdgcn_fence(__ATOMIC_ACQUIRE, "agent");
            asm volatile("s_waitcnt vmcnt(0)" ::: "memory");
        }
    }
    __syncthreads();
}

namespace pg8 {
constexpr int BM = 256, BK = 64, HALF = 128, HTB = HALF * BK * 2, STAGE_BYTES = 8 * HTB, NXCD = 8, WGM = 8;
DI int lds_byte(int r, int c) { const int st = (r >> 4) * 2 + (c >> 5), rr = r & 15, cc = c & 31, ob = rr * 64 + cc * 2; return st * 1024 + (ob ^ (((ob >> 9) & 1) << 5)); }
DI int perm32(int rho) { const int n = rho >> 4, i = rho & 15; return 8 * (i >> 2) + 4 * n + (i & 3); }
DI void stage_rc(int b, int& R, int& C) { const int st = b / 1024, sb = b % 1024, swz = sb ^ (((sb >> 9) & 1) << 5); R = (st >> 1) * 16 + swz / 64; C = (st & 1) * 32 + (swz % 64) / 2; }
struct Unit { int pm, pn; };
struct Gemm { const bf16_t* A; const bf16_t* Bt; int M, N, K, lda, ldb; };
struct StaticOrder {
    int nM, nN, nwg, G, c;
    DI void init(int M, int N, int G_, int c_) { nM = M / BM; nN = N / BM; nwg = nM * nN; G = G_; c = c_; }
    DI bool next(int i, Unit& u) const {
        const long L = (long)i * G + c; if (c < 0 || L >= nwg) return false;
        int wgid = (int)L; { const int q = nwg / NXCD, r = nwg % NXCD, xcd = wgid % NXCD, off = wgid / NXCD; wgid = (xcd < r ? xcd * (q + 1) : r * (q + 1) + (xcd - r) * q) + off; }
        const int nig = WGM * nN, gid = wgid / nig, fm = gid * WGM, gsz = (nM - fm) < WGM ? (nM - fm) : WGM;
        u.pm = fm + ((wgid % nig) % gsz); u.pn = (wgid % nig) / gsz; return true;
    }
};

template <class Epi, class Sched>
DI void gemm_phase(LAS unsigned char* lds, const Gemm g, const Sched& S, const Epi& E, int wave0) {
    const int lane = lane_id_now(), wid = wave0, tid = wid * 64 + lane, wr = wid >> 2, wc = wid & 3, fr = lane & 15, fq = lane >> 4;
    const int K = g.K, nt = K / BK;
    unsigned voffA[2], voffB[2];
#pragma unroll
    for (int i = 0; i < 2; ++i) { int R, C; stage_rc(tid * 16 + i * 8192, R, C);
        const int g_ = R >> 5, Rb = Epi::PERM == 2 ? ((g_ & 3) * 64 + (g_ >> 2) * 32 + perm32(R & 31))
                                   : Epi::PERM ? ((R & ~31) + perm32(R & 31)) : R;
        voffA[i] = (unsigned)(R * g.lda + C) * 2u; voffB[i] = (unsigned)(Rb * g.ldb + C) * 2u; }
    const size_t kstep = (size_t)(BK * 2);
    const size_t hstepA = (size_t)HALF * g.lda * 2, hstepB = (size_t)(Epi::PERM == 2 ? 32 : HALF) * g.ldb * 2;
    const size_t tstepA = 2 * hstepA, tstepB = (size_t)2 * HALF * g.ldb * 2;
    const unsigned ldsw = (unsigned)wid * 1024u;
    const int aoff = lds_byte(wr * 64 + fr, fq * 8), boff = lds_byte(wc * 32 + fr, fq * 8);
#define PG8_SA(b, h) (((b) * 2 + (h)) * HTB)
#define PG8_SB(b, h) ((4 + (b) * 2 + (h)) * HTB)
#define PG8_STAGE(bufoff, gbase, voff) do { _Pragma("unroll") for (int _i = 0; _i < 2; ++_i) \
        __builtin_amdgcn_global_load_lds((const unsigned*)((const char*)(gbase) + (voff)[_i]), (LAS unsigned*)(lds + (bufoff) + ldsw + _i * 8192), 16, 0, 0); } while (0)
#define PG8_LDA(dst, b, h) do { _Pragma("unroll") for (int m = 0; m < 4; ++m) _Pragma("unroll") for (int k = 0; k < 2; ++k) dst[m][k] = *(const LAS bf16x8*)(lds + PG8_SA(b, h) + aoff + m * 2048 + k * 1024); } while (0)
#define PG8_LDB(dst, b, h) do { _Pragma("unroll") for (int n = 0; n < 2; ++n) _Pragma("unroll") for (int k = 0; k < 2; ++k) dst[n][k] = *(const LAS bf16x8*)(lds + PG8_SB(b, h) + boff + n * 2048 + k * 1024); } while (0)
#define PG8_MMA(ai, bj, At, Bt) do { __builtin_amdgcn_s_setprio(1); _Pragma("unroll") for (int m = 0; m < 4; ++m) _Pragma("unroll") for (int n = 0; n < 2; ++n) _Pragma("unroll") for (int k = 0; k < 2; ++k) \
        acc[ai][bj][m][n] = __builtin_amdgcn_mfma_f32_16x16x32_bf16(Bt[n][k], At[m][k], acc[ai][bj][m][n], 0, 0, 0); __builtin_amdgcn_s_setprio(0); } while (0)
#define PG8_WAIT_V(n) asm volatile("s_waitcnt vmcnt(" #n ")" ::: "memory")
#define PG8_WAIT_L(n) asm volatile("s_waitcnt lgkmcnt(" #n ")" ::: "memory")
#define PG8_BAR __builtin_amdgcn_s_barrier()
#define PG8_SCHED __builtin_amdgcn_sched_barrier(0)
    Unit cur, nxt; int ui = 0;
    if (!S.next(0, cur)) return;
    f32x4 acc[2][2][4][2];
#pragma unroll
    for (int a = 0; a < 2; ++a)
#pragma unroll
        for (int b = 0; b < 2; ++b)
#pragma unroll
            for (int m = 0; m < 4; ++m)
#pragma unroll
                for (int n = 0; n < 2; ++n) acc[a][b][m][n] = (f32x4){0.f, 0.f, 0.f, 0.f};
    bf16x8 At[4][2], B0[2][2], B1[2][2];
    const char* cA = (const char*)g.A + (size_t)cur.pm * tstepA; const char* cB = (const char*)g.Bt + (size_t)cur.pn * tstepB;
    PG8_STAGE(PG8_SB(0, 0), cB, voffB); PG8_STAGE(PG8_SB(0, 1), cB + hstepB, voffB); PG8_STAGE(PG8_SA(0, 0), cA, voffA); PG8_STAGE(PG8_SA(0, 1), cA + hstepA, voffA);
    if (wr == 1) PG8_BAR;
    PG8_WAIT_V(2); PG8_BAR;
    PG8_STAGE(PG8_SB(1, 0), cB + kstep, voffB); PG8_STAGE(PG8_SA(1, 0), cA + kstep, voffA); PG8_STAGE(PG8_SB(1, 1), cB + hstepB + kstep, voffB);
    PG8_WAIT_V(6); PG8_BAR;
    for (;;) {
        const bool has_next = S.next(ui + 1, nxt);
        const char* nA = has_next ? (const char*)g.A + (size_t)nxt.pm * tstepA : cA; const char* nB = has_next ? (const char*)g.Bt + (size_t)nxt.pn * tstepB : cB;
#pragma unroll 1
        for (int t = 0; t < nt; t += 2) {
            if constexpr (Epi::MID) { if (t == nt / 2) E.mid(acc, cur, wr, wc, fr, fq); }
            const bool last = (t == nt - 2);
            const char* a1 = cA + (size_t)(t + 1) * kstep;
            const char* a2 = last ? nA : cA + (size_t)(t + 2) * kstep; const char* b2 = last ? nB : cB + (size_t)(t + 2) * kstep;
            const char* a3 = a2 + kstep; const char* b3 = b2 + kstep;
            PG8_LDB(B0, 0, 0); PG8_LDB(B1, 0, 1); PG8_SCHED; PG8_LDA(At, 0, 0); PG8_STAGE(PG8_SA(1, 1), a1 + hstepA, voffA);
            PG8_WAIT_V(8); PG8_WAIT_L(0); PG8_BAR; PG8_MMA(0, 0, At, B0); PG8_MMA(0, 1, At, B1); PG8_BAR; PG8_SCHED;
            PG8_LDA(At, 0, 1); PG8_STAGE(PG8_SB(0, 0), b2, voffB); PG8_STAGE(PG8_SB(0, 1), b2 + hstepB, voffB); PG8_STAGE(PG8_SA(0, 0), a2, voffA);
            PG8_WAIT_V(8); PG8_WAIT_L(0); PG8_BAR; PG8_MMA(1, 0, At, B0); PG8_MMA(1, 1, At, B1); PG8_BAR; PG8_SCHED;
            PG8_LDB(B0, 1, 0); PG8_LDB(B1, 1, 1); PG8_SCHED; PG8_LDA(At, 1, 0); PG8_STAGE(PG8_SA(0, 1), a2 + hstepA, voffA);
            PG8_WAIT_V(8); PG8_WAIT_L(0); PG8_BAR; PG8_MMA(0, 0, At, B0); PG8_MMA(0, 1, At, B1); PG8_BAR; PG8_SCHED;
            PG8_LDA(At, 1, 1); PG8_STAGE(PG8_SB(1, 0), b3, voffB); PG8_STAGE(PG8_SB(1, 1), b3 + hstepB, voffB); PG8_STAGE(PG8_SA(1, 0), a3, voffA);
            PG8_WAIT_V(8); PG8_WAIT_L(0); PG8_BAR; PG8_MMA(1, 0, At, B0); PG8_MMA(1, 1, At, B1); PG8_BAR; PG8_SCHED;
        }
        if (wr == 0) PG8_BAR;
        E(acc, cur, wr, wc, fr, fq);
#ifdef MK_EPI2
        if constexpr (Epi::EPI2) E(acc, cur, wr, wc, fr, fq);
#endif
        if (!has_next) break;
#pragma unroll
        for (int a = 0; a < 2; ++a)
#pragma unroll
            for (int b = 0; b < 2; ++b)
#pragma unroll
                for (int m = 0; m < 4; ++m)
#pragma unroll
                    for (int n = 0; n < 2; ++n) acc[a][b][m][n] = (f32x4){0.f, 0.f, 0.f, 0.f};
        cur = nxt; cA = nA; cB = nB; ++ui;
        if (wr == 1) PG8_BAR;
    }
    PG8_WAIT_V(0);
    PG8_BAR;
#undef PG8_SA
#undef PG8_SB
#undef PG8_STAGE
#undef PG8_LDA
#undef PG8_LDB
#undef PG8_MMA
#undef PG8_WAIT_V
#undef PG8_WAIT_L
#undef PG8_BAR
#undef PG8_SCHED
}
}

using pg8::Unit;
typedef f32x4 AccT[2][2][4][2];

DI void st_bf4(bf16_t* p, f32x4 v) { u32x2 w; w.x = cvtpk(v[0], v[1]); w.y = cvtpk(v[2], v[3]); *(GAS u32x2*)p = w; }
DI float sq4(f32x4 v) { return (v[0] * v[0] + v[1] * v[1]) + (v[2] * v[2] + v[3] * v[3]); }
DI float st_bf4_sq(bf16_t* p, f32x4 v) { u32x2 w; w.x = cvtpk(v[0], v[1]); w.y = cvtpk(v[2], v[3]); *(GAS u32x2*)p = w;
    const float a = __builtin_bit_cast(float, w[0] << 16), b = __builtin_bit_cast(float, w[0] & 0xffff0000u), c = __builtin_bit_cast(float, w[1] << 16), d = __builtin_bit_cast(float, w[1] & 0xffff0000u);
    return (a * a + b * b) + (c * c + d * d); }
DI float st_row64(bf16_t* rowp, const f32x16& o0, const f32x16& o1, float scale, int h) {
    float ssq = 0.f; u32x2 pc[8];
#pragma unroll
    for (int g = 0; g < 8; ++g) { const f32x16& o = g < 4 ? o0 : o1; const int b4 = (g & 3) * 4;
        u32x2 w; w.x = cvtpk(o[b4] * scale, o[b4 + 1] * scale); w.y = cvtpk(o[b4 + 2] * scale, o[b4 + 3] * scale); pc[g] = w;
        const float a = __builtin_bit_cast(float, w[0] << 16), b = __builtin_bit_cast(float, w[0] & 0xffff0000u), c = __builtin_bit_cast(float, w[1] << 16), d = __builtin_bit_cast(float, w[1] & 0xffff0000u);
        ssq += (a * a + b * b) + (c * c + d * d); }
#pragma unroll
    for (int k = 0; k < 4; ++k) {
        const u32x2 snd = h ? pc[2 * k] : pc[2 * k + 1]; u32x2 rcv;
        rcv.x = (unsigned)__shfl_xor((int)snd.x, 32); rcv.y = (unsigned)__shfl_xor((int)snd.y, 32);
        u32x4 out; if (h) { out.x = rcv.x; out.y = rcv.y; out.z = pc[2 * k + 1].x; out.w = pc[2 * k + 1].y; } else { out.x = pc[2 * k].x; out.y = pc[2 * k].y; out.z = rcv.x; out.w = rcv.y; }
        *(GAS u32x4*)(rowp + 16 * k + (h ? 8 : 0)) = out; }
    return ssq;
}
DI float sum16(const float* p) { const f32x4 a = *(const GAS f32x4*)p, b = *(const GAS f32x4*)(p + 4), c = *(const GAS f32x4*)(p + 8), d = *(const GAS f32x4*)(p + 12);
    return (((a[0] + a[1]) + (a[2] + a[3])) + ((b[0] + b[1]) + (b[2] + b[3]))) + (((c[0] + c[1]) + (c[2] + c[3])) + ((d[0] + d[1]) + (d[2] + d[3]))); }
DI float sum16_q(const float* p, int fq) { const f32x4 a = *(const GAS f32x4*)(p + 4 * fq); float s = (a[0] + a[1]) + (a[2] + a[3]); s += __shfl_xor(s, 16); s += __shfl_xor(s, 32); return s; }
DI float sum4(const float* p) { const f32x4 a = *(const GAS f32x4*)p; return (a[0] + a[1]) + (a[2] + a[3]); }

DI void st_bf8(bf16_t* p, f32x4 a, f32x4 b) { u32x4 w; w.x = cvtpk(a[0], a[1]); w.y = cvtpk(a[2], a[3]); w.z = cvtpk(b[0], b[1]); w.w = cvtpk(b[2], b[3]); *(GAS u32x4*)p = w; }
struct EpiInProj {
    static constexpr bool MID = false; static constexpr bool EPI2 = false; static constexpr bool PERM = true;
    unsigned char* ws_; int l;
    DI void operator()(const AccT& acc, const Unit& u, int wr, int wc, int fr, int fq) const {
        unsigned char* ws = launder(ws_);
        unsigned char* A = ws + WS_A;
        const float* ss1 = (const float*)(ws + WS_SS1); float* sscq = (float*)(ws + WS_SSCQ); float* ssckv = (float*)(ws + WS_SSCKV);
        bf16_t* QA = (bf16_t*)(A + A_QA); bf16_t* KC = (bf16_t*)(A + A_KC); bf16_t* VC = (bf16_t*)(A + A_VC); bf16_t* CQKV = (bf16_t*)(A + A_CQKV); bf16_t* KR = (bf16_t*)(A + A_KR); float* GATES = (float*)(A + A_GATES);
        const float* cosA = (const float*)(ws + WS_W + W_COSA); const float* sinA = (const float*)(ws + WS_W + W_SINA); const float* cosB = (const float*)(ws + WS_W + W_COSB); const float* sinB = (const float*)(ws + WS_W + W_SINB);
        const int pn = u.pn;
#pragma unroll
        for (int ai = 0; ai < 2; ++ai)
#pragma unroll
            for (int m = 0; m < 4; ++m) {
                const int row = u.pm * 256 + ai * 128 + wr * 64 + m * 16 + fr, t = row & (SEQ - 1), b = row >> 12;
                const float rstd = rsqrtf(sum16_q(ss1 + (size_t)row * 16, fq) * (1.0f / 1024.0f) + NORM_EPS);
                if (pn < 5) {
                    const bool roped = pn < 2 || wc < 2;
                    if (roped) {
                        const f32x4 c0 = *(const GAS f32x4*)(cosA + t * 32 + 8 * fq), c1 = *(const GAS f32x4*)(cosA + t * 32 + 8 * fq + 4);
                        const f32x4 s0 = *(const GAS f32x4*)(sinA + t * 32 + 8 * fq), s1 = *(const GAS f32x4*)(sinA + t * 32 + 8 * fq + 4);
                        const f32x4 l0 = acc[ai][0][m][0] * rstd, l1 = acc[ai][0][m][1] * rstd, h0 = acc[ai][1][m][0] * rstd, h1 = acc[ai][1][m][1] * rstd;
                        bf16_t* dst; float sc;
                        if (pn < 2) { dst = QA + (size_t)row * 512 + (pn * 4 + wc) * 64 + 8 * fq; sc = QS_NSA; }
                        else { dst = KC + (size_t)(pn - 2) * KVSLOT + ((size_t)(b * 2 + wc) * SEQ + t) * 64 + 8 * fq; sc = 1.0f; }
                        st_bf8(dst, (l0 * c0 - h0 * s0) * sc, (l1 * c1 - h1 * s1) * sc);
                        st_bf8(dst + 32, (h0 * c0 + l0 * s0) * sc, (h1 * c1 + l1 * s1) * sc);
                    } else {
                        bf16_t* dst = VC + (size_t)(pn - 2) * KVSLOT + ((size_t)(b * 2 + (wc - 2)) * SEQ + t) * 64 + 8 * fq;
                        st_bf8(dst, acc[ai][0][m][0] * rstd, acc[ai][0][m][1] * rstd);
                        st_bf8(dst + 32, acc[ai][1][m][0] * rstd, acc[ai][1][m][1] * rstd);
                    }
                } else if (pn == 5) {
                    float q = 0.f;
#pragma unroll
                    for (int bj = 0; bj < 2; ++bj) { const f32x4 x0 = acc[ai][bj][m][0] * rstd, x1 = acc[ai][bj][m][1] * rstd; q += sq4(x0) + sq4(x1); st_bf8(CQKV + (size_t)row * KUP + bj * 128 + wc * 32 + 8 * fq, x0, x1); }
                    q += __shfl_xor(q, 16); q += __shfl_xor(q, 32);
                    if (fq == 0) sscq[(size_t)row * 4 + wc] = q;
                } else {
                    { const f32x4 x0 = acc[ai][0][m][0] * rstd, x1 = acc[ai][0][m][1] * rstd; float q = sq4(x0) + sq4(x1); st_bf8(CQKV + (size_t)row * KUP + 256 + wc * 32 + 8 * fq, x0, x1);
                      q += __shfl_xor(q, 16); q += __shfl_xor(q, 32);
                      if (fq == 0) ssckv[(size_t)row * 4 + wc] = q; }
                    if (wc == 0) {
                        const f32x4 c4 = *(const GAS f32x4*)(cosB + t * 16 + 4 * fq), s4 = *(const GAS f32x4*)(sinB + t * 16 + 4 * fq);
                        const f32x4 x0 = acc[ai][1][m][0] * rstd, x1 = acc[ai][1][m][1] * rstd;
                        bf16_t* dst = KR + (size_t)row * 32 + 4 * fq;
                        st_bf4(dst, x0 * c4 - x1 * s4); st_bf4(dst + 16, x1 * c4 + x0 * s4);
                    } else if (wc == 1 && fq < 3) {
#pragma unroll
                        for (int n = 0; n < 2; ++n) { const f32x4 x = acc[ai][1][m][n] * rstd; f32x4 sg;
#pragma unroll
                            for (int j = 0; j < 4; ++j) sg[j] = 1.0f / (1.0f + __expf(-x[j]));
                            *(GAS f32x4*)(GATES + (size_t)row * 24 + 8 * fq + 4 * n) = sg; }
                    }
                }
                if (m == 3) asm volatile("" ::: "memory");
            }
    }
};

struct EpiUp {
    static constexpr bool MID = false; static constexpr bool EPI2 = false; static constexpr bool PERM = true;
    unsigned char* ws_; int l;
    DI void operator()(const AccT& acc, const Unit& u, int wr, int wc, int fr, int fq) const {
        unsigned char* ws = launder(ws_);
        unsigned char* A = ws + WS_A;
        const int pn = u.pn;
        const float* ssp = (const float*)(ws + (pn < 3 ? WS_SSCQ : WS_SSCKV));
        const float ssdiv = pn < 3 ? (1.0f / 256.0f) : (1.0f / 128.0f), ssmul = pn < 3 ? QS_MLA : 1.0f;
        const int row0 = u.pm * 256 + wr * 64 + fr;
        if (pn < 2) {
            bf16_t* QM = (bf16_t*)(A + A_QM);
#pragma unroll
            for (int ai = 0; ai < 2; ++ai)
#pragma unroll
                for (int m = 0; m < 4; ++m) { const int row = row0 + ai * 128 + m * 16; const float sc = rsqrtf(sum4(ssp + (size_t)row * 4) * ssdiv + NORM_EPS) * ssmul;
#pragma unroll
                    for (int bj = 0; bj < 2; ++bj) { const int head = pn * 4 + bj * 2 + (wc >> 1);
                        st_bf8(QM + (size_t)row * 768 + head * 96 + 32 * (wc & 1) + 8 * fq, acc[ai][bj][m][0] * sc, acc[ai][bj][m][1] * sc); }
                    if (m == 3) asm volatile("" ::: "memory"); }
        } else if (pn == 2) {
            bf16_t* QM = (bf16_t*)(A + A_QM);
            const float* cosB = (const float*)(ws + WS_W + W_COSB); const float* sinB = (const float*)(ws + WS_W + W_SINB);
#pragma unroll
            for (int ai = 0; ai < 2; ++ai)
#pragma unroll
                for (int m = 0; m < 4; ++m) { const int row = row0 + ai * 128 + m * 16, t = row & (SEQ - 1); const float sc = rsqrtf(sum4(ssp + (size_t)row * 4) * ssdiv + NORM_EPS) * ssmul;
                    const f32x4 c4 = *(const GAS f32x4*)(cosB + t * 16 + 4 * fq), s4 = *(const GAS f32x4*)(sinB + t * 16 + 4 * fq);
#pragma unroll
                    for (int bj = 0; bj < 2; ++bj) { const int hd = bj * 4 + wc;
                        const f32x4 x0 = acc[ai][bj][m][0] * sc, x1 = acc[ai][bj][m][1] * sc;
                        bf16_t* dst = QM + (size_t)row * 768 + hd * 96 + 64 + 4 * fq;
                        st_bf4(dst, x0 * c4 - x1 * s4); st_bf4(dst + 16, x1 * c4 + x0 * s4); }
                    if (m == 3) asm volatile("" ::: "memory"); }
        } else {
            bf16_t* base = (bf16_t*)(A + (pn < 5 ? A_KN : A_VM)); const int pq = (pn < 5) ? pn - 3 : pn - 5;
#pragma unroll
            for (int ai = 0; ai < 2; ++ai)
#pragma unroll
                for (int m = 0; m < 4; ++m) { const int row = row0 + ai * 128 + m * 16, t = row & (SEQ - 1), b = row >> 12; const float sc = rsqrtf(sum4(ssp + (size_t)row * 4) * ssdiv + NORM_EPS);
#pragma unroll
                    for (int bj = 0; bj < 2; ++bj) { const int head = pq * 4 + bj * 2 + (wc >> 1);
                        st_bf8(base + ((size_t)(b * 8 + head) * SEQ + t) * 64 + 32 * (wc & 1) + 8 * fq, acc[ai][bj][m][0] * sc, acc[ai][bj][m][1] * sc); }
                    if (m == 3) asm volatile("" ::: "memory"); }
        }
    }
};

struct EpiSlab {
    static constexpr bool MID = false; static constexpr bool EPI2 = false; static constexpr bool PERM = true;
    unsigned char* ws_; int slab;
    DI void operator()(const AccT& acc, const Unit& u, int wr, int wc, int fr, int fq) const {
        float* S = (float*)(launder(ws_) + WS_A + A_HIDC) + (size_t)slab * 4096 * 256;
#pragma unroll
        for (int ai = 0; ai < 2; ++ai)
#pragma unroll
            for (int m = 0; m < 4; ++m) { const int row = u.pm * 256 + ai * 128 + wr * 64 + m * 16 + fr;
#pragma unroll
                for (int bj = 0; bj < 2; ++bj)
#pragma unroll
                    for (int n = 0; n < 2; ++n) *(GAS f32x4*)(S + (size_t)row * 256 + bj * 128 + wc * 32 + 8 * fq + 4 * n) = acc[ai][bj][m][n]; }
    }
};

template <bool NORM2>
struct EpiResid {
    static constexpr bool MID = NORM2; static constexpr bool EPI2 = false; static constexpr bool PERM = true;
    unsigned char* ws_; int ssi;
    DI static float rstd8(const float* p) { const f32x4 a = *(const GAS f32x4*)p, b = *(const GAS f32x4*)(p + 4);
        return rsqrtf((((a[0] + a[1]) + (a[2] + a[3])) + ((b[0] + b[1]) + (b[2] + b[3]))) * (1.0f / 512.0f) + NORM_EPS); }
    DI void mid(AccT& acc, const Unit& u, int wr, int wc, int fr, int fq) const {
        unsigned char* ws = launder(ws_); const float* ssa = (const float*)(ws + WS_SSA); const float* ssb = (const float*)(ws + WS_SSB);
#pragma unroll
        for (int ai = 0; ai < 2; ++ai)
#pragma unroll
            for (int m = 0; m < 4; ++m) { const int row = u.pm * 256 + ai * 128 + wr * 64 + m * 16 + fr;
                const float ratio = rstd8(ssa + (size_t)row * 8) / rstd8(ssb + (size_t)row * 8);
#pragma unroll
                for (int bj = 0; bj < 2; ++bj)
#pragma unroll
                    for (int n = 0; n < 2; ++n) acc[ai][bj][m][n] *= ratio;
                if (m & 1) asm volatile("" ::: "memory"); }
    }
    DI void operator()(const AccT& acc, const Unit& u, int wr, int wc, int fr, int fq) const {
        unsigned char* ws = launder(ws_);
        bf16_t* XB = (bf16_t*)(ws + WS_XB); float* ss = (float*)(ws + (ssi ? WS_SS2 : WS_SS1)); const float* ssb = (const float*)(ws + WS_SSB);
#pragma unroll
        for (int ai = 0; ai < 2; ++ai) {
            u32x4 old_[4][2]; float sc_[4];
#pragma unroll
            for (int m = 0; m < 4; ++m) { const int row = u.pm * 256 + ai * 128 + wr * 64 + m * 16 + fr;
#pragma unroll
                for (int bj = 0; bj < 2; ++bj) old_[m][bj] = *(const GAS u32x4*)(XB + (size_t)row * 1024 + u.pn * 256 + bj * 128 + wc * 32 + 8 * fq);
                sc_[m] = NORM2 ? rstd8(ssb + (size_t)row * 8) : 1.0f; }
#pragma unroll
            for (int m = 0; m < 4; ++m) { const int row = u.pm * 256 + ai * 128 + wr * 64 + m * 16 + fr; float q = 0.f;
                const float sc = sc_[m];
#pragma unroll
                for (int bj = 0; bj < 2; ++bj) { const size_t off = (size_t)row * 1024 + u.pn * 256 + bj * 128 + wc * 32 + 8 * fq;
                    const u32x4 o = old_[m][bj];
                    f32x4 x0, x1;
                    x0[0] = __builtin_bit_cast(float, o[0] << 16); x0[1] = __builtin_bit_cast(float, o[0] & 0xffff0000u); x0[2] = __builtin_bit_cast(float, o[1] << 16); x0[3] = __builtin_bit_cast(float, o[1] & 0xffff0000u);
                    x1[0] = __builtin_bit_cast(float, o[2] << 16); x1[1] = __builtin_bit_cast(float, o[2] & 0xffff0000u); x1[2] = __builtin_bit_cast(float, o[3] << 16); x1[3] = __builtin_bit_cast(float, o[3] & 0xffff0000u);
                    x0 += NORM2 ? acc[ai][bj][m][0] * sc : acc[ai][bj][m][0]; x1 += NORM2 ? acc[ai][bj][m][1] * sc : acc[ai][bj][m][1];
                    u32x4 w; w.x = cvtpk(x0[0], x0[1]); w.y = cvtpk(x0[2], x0[3]); w.z = cvtpk(x1[0], x1[1]); w.w = cvtpk(x1[2], x1[3]); *(GAS u32x4*)(XB + off) = w;
#pragma unroll
                    for (int j = 0; j < 4; ++j) { const float a = __builtin_bit_cast(float, w[j] << 16), b = __builtin_bit_cast(float, w[j] & 0xffff0000u); q += a * a + b * b; } }
                q += __shfl_xor(q, 16); q += __shfl_xor(q, 32);
                if (fq == 0) ss[(size_t)row * 16 + u.pn * 4 + wc] = q; }
            asm volatile("" ::: "memory"); }
    }
};

struct EpiFF1 {
    static constexpr bool MID = false; static constexpr bool EPI2 = true; static constexpr int PERM = 2;
    unsigned char* ws_; int l;
    mutable float rs_[8]; mutable int pm_ = -1;
    DI void operator()(const AccT& acc, const Unit& u, int wr, int wc, int fr, int fq) const {
        unsigned char* ws = launder(ws_); const float* ss2 = (const float*)(ws + WS_SS2); bf16_t* HID = (bf16_t*)(ws + WS_A);
        if (u.pm != pm_) {
            pm_ = u.pm;
#pragma unroll
            for (int g = 0; g < 8; ++g) { const int row = u.pm * 256 + (g >> 2) * 128 + wr * 64 + (g & 3) * 16 + fr;
                rs_[g] = rsqrtf(sum16_q(ss2 + (size_t)row * 16, fq) * (1.0f / 1024.0f) + NORM_EPS);
                if ((g & 3) == 3) asm volatile("" ::: "memory"); }
        }
        const bool hi = (fr & 8) != 0;
#pragma unroll
        for (int ai = 0; ai < 2; ++ai)
#pragma unroll
            for (int m = 0; m < 4; ++m) { const int row8 = u.pm * 256 + ai * 128 + wr * 64 + m * 16 + (fr & 7);
                const float rstd = rs_[ai * 4 + m];
                u32x4 w[2];
#pragma unroll
                for (int bj = 0; bj < 2; ++bj) { f32x4 x0 = acc[ai][bj][m][0] * rstd, x1 = acc[ai][bj][m][1] * rstd;
#pragma unroll
                    for (int j = 0; j < 4; ++j) { const float r0 = fmaxf(x0[j], 0.f), r1 = fmaxf(x1[j], 0.f); x0[j] = r0 * r0; x1[j] = r1 * r1; }
                    w[bj].x = cvtpk(x0[0], x0[1]); w[bj].y = cvtpk(x0[2], x0[3]); w[bj].z = cvtpk(x1[0], x1[1]); w[bj].w = cvtpk(x1[2], x1[3]); }
                u32x4 rcv, va, vb;
#pragma unroll
                for (int j = 0; j < 4; ++j) { const unsigned snd = hi ? w[0][j] : w[1][j];
                    rcv[j] = (unsigned)__builtin_amdgcn_update_dpp(0, (int)snd, 0x128, 0xf, 0xf, false);
                    va[j] = hi ? rcv[j] : w[0][j]; vb[j] = hi ? w[1][j] : rcv[j]; }
                bf16_t* dst = HID + (size_t)row8 * D_FF + u.pn * 256 + wc * 64 + (hi ? 32 : 0) + 8 * fq;
                __builtin_nontemporal_store(va, (GAS u32x4*)dst);
                __builtin_nontemporal_store(vb, (GAS u32x4*)(dst + (size_t)8 * D_FF));
                if (m == 3) asm volatile("" ::: "memory"); }
    }
};

DI int rope32_dim(int pos) { return 4 * (pos >> 3) + (pos & 3) + 16 * ((pos >> 2) & 1); }
DI int win_src(int P) {
    const int tile = P >> 8, p = P & 255, bj = p >> 7, wc = (p >> 5) & 3, pos = p & 31;
    if (tile < 2) return (tile * 4 + wc) * 64 + 32 * bj + pos;
    if (tile < 5) { const int base = 512 + (tile - 2) * 256;
        return wc < 2 ? base + wc * 64 + 32 * bj + pos : base + 128 + (wc - 2) * 64 + 32 * bj + pos; }
    if (tile == 5) return 1304 + p;
    if (bj == 0) return 1560 + (p & 127);
    if (wc == 0) return 1688 + rope32_dim(pos);
    if (wc == 1) return pos < 24 ? 1280 + pos : -1;
    return -1;
}
DI int wup_src(int P) {
    const int tile = P >> 8, p = P & 255;
    if (tile < 2) return (tile * 4 + (p >> 6)) * 96 + (p & 63);
    if (tile == 2) return (p >> 5) * 96 + 64 + rope32_dim(p & 31);
    const int q = P - 768;
    if (q < 512) return (q >> 6) * 128 + (q & 63);
    return ((q - 512) >> 6) * 128 + 64 + (q & 63);
}
DI void transpose_item(const float* W, int ldw, const float* gain, int src, bf16_t* WT, int ldwt, int k0w, int k0t, int n0, LAS float* scr, int lane) {
    const int nn = lane & 31, kh = lane >> 5;
    float v[32], gv[32];
#pragma unroll
    for (int i = 0; i < 32; ++i) { const int kk = 2 * i + kh;
        v[i] = src >= 0 ? __builtin_nontemporal_load((const GAS float*)(W + (size_t)(k0w + kk) * ldw + src)) : 0.f;
        gv[i] = gain ? *(const GAS float*)(gain + k0w + kk) : 1.0f; }
#pragma unroll
    for (int i = 0; i < 32; ++i) scr[(2 * i + kh) * 33 + nn] = v[i] * gv[i];
    asm volatile("s_waitcnt lgkmcnt(0)" ::: "memory");
    const int c = lane & 7;
#pragma unroll
    for (int j = 0; j < 4; ++j) { const int n = (lane >> 3) + 8 * j; const LAS float* sp = scr + (8 * c) * 33 + n;
        u32x4 o; o.x = cvtpk(sp[0], sp[33]); o.y = cvtpk(sp[2 * 33], sp[3 * 33]); o.z = cvtpk(sp[4 * 33], sp[5 * 33]); o.w = cvtpk(sp[6 * 33], sp[7 * 33]);
        *(u32x4*)(WT + (size_t)(n0 + n) * ldwt + k0t + 8 * c) = o; }
    asm volatile("s_waitcnt lgkmcnt(0)" ::: "memory");
}

constexpr int U_WIN = 56 * 16, U_W1 = 8 * 32, U_WUP = 56 * 6, U_WOUT = 32 * 16, U_WFF1 = 128 * 16, U_WFF2 = 32 * 64;
constexpr int U_LAYER = U_WIN + 2 * U_W1 + U_WUP + U_WOUT + U_WFF1 + U_WFF2;

DI void convert_weights(const Params& p, LAS unsigned char* lds, int wave, int l_lo, int l_hi, int gw, int NGW) {
    const int lane = lane_id_now();
    unsigned char* ws = launder(p.ws);
    unsigned char* wsw = ws + WS_W;
    LAS float* scr = (LAS float*)lds + wave * (64 * 33);
    const int nn = lane & 31;
    for (int uu = l_lo * U_LAYER + gw; uu < l_hi * U_LAYER; uu += NGW) {
        const int l = uu / U_LAYER; int r = uu % U_LAYER;
        if (r < U_WIN) { const int kt = r / 56, nt = r % 56;
            transpose_item(p.in[2] + (size_t)l * 1024 * IN_WIDTH, IN_WIDTH, p.in[1] + l * 1024, win_src(nt * 32 + nn), (bf16_t*)(wsw + W_WIN + l * SZ_WIN), 1024, kt * 64, kt * 64, nt * 32, scr, lane); continue; }
        r -= U_WIN;
        if (r < U_W1) { const int kt = r / 8, nt = r % 8;
            transpose_item(p.in[4] + (size_t)l * 2048 * 256, 256, nullptr, nt * 32 + nn, (bf16_t*)(wsw + W_W1K + l * SZ_W1), 2048, kt * 64, kt * 64, nt * 32, scr, lane); continue; }
        r -= U_W1;
        if (r < U_W1) { const int kt = r / 8, nt = r % 8;
            transpose_item(p.in[7] + (size_t)l * 2048 * 256, 256, nullptr, nt * 32 + nn, (bf16_t*)(wsw + W_W1V + l * SZ_W1), 2048, kt * 64, kt * 64, nt * 32, scr, lane); continue; }
        r -= U_W1;
        if (r < U_WUP) { const int kt = r / 56, nt = r % 56; const int P = nt * 32 + nn; const bool isq = (nt * 32) < 768;
            bf16_t* WT = (bf16_t*)(wsw + W_WUP + l * SZ_WUP);
            if (isq) transpose_item(p.in[10] + (size_t)l * 256 * 768, 768, p.in[9] + l * 256, kt < 4 ? wup_src(P) : -1, WT, KUP, kt < 4 ? kt * 64 : 0, kt * 64, nt * 32, scr, lane);
            else transpose_item(p.in[12] + (size_t)l * 128 * 1024, 1024, p.in[11] + l * 128, kt >= 4 ? wup_src(P) : -1, WT, KUP, kt >= 4 ? (kt - 4) * 64 : 0, kt * 64, nt * 32, scr, lane);
            continue; }
        r -= U_WUP;
        if (r < U_WOUT) { const int kt = r / 32, nt = r % 32;
            const float* gn = kt < 8 ? p.in[13] + l * 512 : p.in[14] + l * 512 - 512;
            transpose_item(p.in[15] + (size_t)l * 1024 * 1024, 1024, gn, nt * 32 + nn, (bf16_t*)(wsw + W_WOUT + l * SZ_WOUT), 1024, kt * 64, kt * 64, nt * 32, scr, lane); continue; }
        r -= U_WOUT;
        if (r < U_WFF1) { const int kt = r / 128, nt = r % 128;
            transpose_item(p.in[17] + (size_t)l * 1024 * 4096, 4096, p.in[16] + l * 1024, nt * 32 + nn, (bf16_t*)(wsw + W_WFF1 + l * SZ_WFF), 1024, kt * 64, kt * 64, nt * 32, scr, lane); continue; }
        r -= U_WFF1;
        { const int kt = r / 32, nt = r % 32;
            transpose_item(p.in[18] + (size_t)l * 4096 * 1024, 1024, nullptr, nt * 32 + nn, (bf16_t*)(wsw + W_WFF2 + l * SZ_WFF), 4096, kt * 64, kt * 64, nt * 32, scr, lane); }
    }
}

DI void prologue(const Params& p, LAS unsigned char* lds, int tid_) {
    const int lane = lane_id_now(), wave = tid_, tid = wave * 64 + lane;
    unsigned char* ws = launder(p.ws);
    unsigned char* wsw = ws + WS_W;
    LAS float* scr = (LAS float*)lds + wave * (64 * 33);
    const int G = gridDim.x, bx = blockIdx.x, gw = bx * NWAVES + wave, NGW = G * NWAVES;
    const int nn = lane & 31;
    convert_weights(p, lds, wave, 0, 1, gw, NGW);
    for (int uu = gw; uu < DEPTH * 2 * 32; uu += NGW) {
        const int lk = uu >> 5, sl = uu & 31, l = lk >> 1, kv = lk & 1;
        const float* pos = (kv ? p.in[6] : p.in[3]) + (size_t)l * 2048 + sl * 64; const float* w1 = (kv ? p.in[7] : p.in[4]) + ((size_t)l * 2048 + sl * 64) * 256 + 4 * lane;
        f32x4 a = {0.f, 0.f, 0.f, 0.f};
#pragma unroll 16
        for (int k = 0; k < 64; ++k) a += __builtin_nontemporal_load((const GAS f32x4*)(w1 + (size_t)k * 256)) * pos[k];
        *(f32x4*)((float*)(wsw + W_BIAS1) + (size_t)uu * 256 + 4 * lane) = a;
    }
    for (int e = bx * NTHR + tid; e < SEQ * 32; e += G * NTHR) { const int t = e >> 5, i = e & 31;
        const float ang = (float)t * (1.0f / powf(10000.0f, (float)(2 * i) / 64.0f));
        ((float*)(wsw + W_COSA))[e] = cosf(ang); ((float*)(wsw + W_SINA))[e] = sinf(ang); }
    for (int e = bx * NTHR + tid; e < SEQ * 16; e += G * NTHR) { const int t = e >> 4, i = e & 15;
        const float ang = (float)t * (1.0f / powf(10000.0f, (float)(2 * i) / 32.0f));
        ((float*)(wsw + W_COSB))[e] = cosf(ang); ((float*)(wsw + W_SINB))[e] = sinf(ang); }
    {
        const float* x = p.in[0]; bf16_t* XB = (bf16_t*)(ws + WS_XB); float* ss = (float*)(ws + WS_SS1);
        for (int row0 = gw * 4; row0 < NTOK; row0 += NGW * 4) {
            f32x4 v[4][4];
#pragma unroll
            for (int rr = 0; rr < 4; ++rr)
#pragma unroll
                for (int j = 0; j < 4; ++j) v[rr][j] = *((const GAS f32x4*)(x + (size_t)(row0 + rr) * 1024) + lane + 64 * j);
#pragma unroll
            for (int rr = 0; rr < 4; ++rr) { const int row = row0 + rr; float q = 0.f;
#pragma unroll
                for (int j = 0; j < 4; ++j) { u32x2 w; w.x = cvtpk(v[rr][j][0], v[rr][j][1]); w.y = cvtpk(v[rr][j][2], v[rr][j][3]); *(GAS u32x2*)(XB + (size_t)row * 1024 + 256 * j + 4 * lane) = w;
                    f32x4 r; r[0] = __builtin_bit_cast(float, w[0] << 16); r[1] = __builtin_bit_cast(float, w[0] & 0xffff0000u); r[2] = __builtin_bit_cast(float, w[1] << 16); r[3] = __builtin_bit_cast(float, w[1] & 0xffff0000u); q += sq4(r); }
                q = wsum(q);
                if (lane < 16) ss[(size_t)row * 16 + lane] = lane == 0 ? q : 0.f; }
        }
    }
    __syncthreads();
}

DI void norm_mix_phase(const Params& p, int l, int tid_) {
    const int tid = tid_ * 64 + lane_id_now();
    const int lane = tid & 63, gw = blockIdx.x * NWAVES + (tid >> 6), NGW = gridDim.x * NWAVES;
    unsigned char* ws = launder(p.ws);
    const bf16_t* OAB = (const bf16_t*)(ws + WS_OAB); bf16_t* MIX = (bf16_t*)(ws + WS_A + A_MIX);
    const float* ga = p.in[13] + l * 512 + lane * 8; const float* gb = p.in[14] + l * 512 + lane * 8;
    float g_a[8], g_b[8];
#pragma unroll
    for (int j = 0; j < 8; ++j) { g_a[j] = ga[j]; g_b[j] = gb[j]; }
    for (int row = gw; row < NTOK; row += NGW) {
        const u32x4 a = *(const u32x4*)(OAB + (size_t)row * 1024 + lane * 8), b = *(const u32x4*)(OAB + (size_t)row * 1024 + 512 + lane * 8);
        float va[8], vb[8]; float qa = 0.f, qb = 0.f;
#pragma unroll
        for (int j = 0; j < 4; ++j) { va[2 * j] = __builtin_bit_cast(float, a[j] << 16); va[2 * j + 1] = __builtin_bit_cast(float, a[j] & 0xffff0000u);
            vb[2 * j] = __builtin_bit_cast(float, b[j] << 16); vb[2 * j + 1] = __builtin_bit_cast(float, b[j] & 0xffff0000u); }
#pragma unroll
        for (int j = 0; j < 8; ++j) { qa += va[j] * va[j]; qb += vb[j] * vb[j]; }
        qa = wsum(qa); qb = wsum(qb);
        const float ra = rsqrtf(qa * (1.0f / 512.0f) + NORM_EPS), rb = rsqrtf(qb * (1.0f / 512.0f) + NORM_EPS);
        u32x4 oa, ob;
#pragma unroll
        for (int j = 0; j < 4; ++j) { oa[j] = cvtpk(va[2 * j] * ra * g_a[2 * j], va[2 * j + 1] * ra * g_a[2 * j + 1]); ob[j] = cvtpk(vb[2 * j] * rb * g_b[2 * j], vb[2 * j + 1] * rb * g_b[2 * j + 1]); }
        *(u32x4*)(MIX + (size_t)row * 1024 + lane * 8) = oa; *(u32x4*)(MIX + (size_t)row * 1024 + 512 + lane * 8) = ob;
    }
}
DI void final_norm_phase(const Params& p, int tid_) {
    const int tid = tid_ * 64 + lane_id_now();
    const int lane = tid & 63, gw = blockIdx.x * NWAVES + (tid >> 6), NGW = gridDim.x * NWAVES;
    unsigned char* ws = launder(p.ws);
    float* X = p.out; const bf16_t* XB = (const bf16_t*)(ws + WS_XB); const float* ss = (const float*)(ws + WS_SS1); const float* gn = p.in[19];
    for (int row0 = gw * 4; row0 < NTOK; row0 += NGW * 4) {
        u32x2 o[4][4]; float rstd[4];
#pragma unroll
        for (int rr = 0; rr < 4; ++rr) { rstd[rr] = rsqrtf(sum16(ss + (size_t)(row0 + rr) * 16) * (1.0f / 1024.0f) + NORM_EPS);
#pragma unroll
            for (int j = 0; j < 4; ++j) o[rr][j] = *(const GAS u32x2*)(XB + (size_t)(row0 + rr) * 1024 + 256 * j + 4 * lane); }
#pragma unroll
        for (int rr = 0; rr < 4; ++rr)
#pragma unroll
            for (int j = 0; j < 4; ++j) { const f32x4 g = *((const GAS f32x4*)gn + 64 * j + lane);
                f32x4 x; x[0] = __builtin_bit_cast(float, o[rr][j][0] << 16); x[1] = __builtin_bit_cast(float, o[rr][j][0] & 0xffff0000u); x[2] = __builtin_bit_cast(float, o[rr][j][1] << 16); x[3] = __builtin_bit_cast(float, o[rr][j][1] & 0xffff0000u);
                __builtin_nontemporal_store(x * rstd[rr] * g, (GAS f32x4*)(X + (size_t)(row0 + rr) * 1024) + 64 * j + lane); }
    }
}
DI void cmp2_phase(const Params& p, int l, LAS unsigned char* lds, int tid_) {
    const int tid = tid_ * 64 + lane_id_now();
    const int lane = tid & 63, w = tid_, kvw = w >> 2, nb = w & 3;
    constexpr int HSTR = 528;
    LAS unsigned char* hidb = lds;
    LAS float* b1 = (LAS float*)(lds + 32768);
    unsigned char* ws = launder(p.ws);
    const float* slabs = (const float*)(ws + WS_A + A_HIDC);
    bf16x8 wf[8];
    { const float* w2 = (kvw ? p.in[8] : p.in[5]) + (size_t)l * 256 * 64 + nb * 16 + (lane & 15);
      float wv[8][8];
#pragma unroll
      for (int ks = 0; ks < 8; ++ks)
#pragma unroll
          for (int e = 0; e < 8; ++e) wv[ks][e] = *(const GAS float*)(w2 + (size_t)(ks * 32 + 8 * (lane >> 4) + e) * 64);
#pragma unroll
      for (int ks = 0; ks < 8; ++ks) { u32x4 t; t.x = cvtpk(wv[ks][0], wv[ks][1]); t.y = cvtpk(wv[ks][2], wv[ks][3]); t.z = cvtpk(wv[ks][4], wv[ks][5]); t.w = cvtpk(wv[ks][6], wv[ks][7]); wf[ks] = __builtin_bit_cast(bf16x8, t); } }
    __syncthreads();
    { const int kv_ = tid >> 8, n_ = tid & 255;
      const float* b1p = (const float*)(ws + WS_W + W_BIAS1) + (size_t)(l * 2 + kv_) * 32 * 256 + n_;
      float bv[32];
#pragma unroll
      for (int sl = 0; sl < 32; ++sl) bv[sl] = *(const GAS float*)(b1p + sl * 256);
      float a = 0.f;
#pragma unroll
      for (int sl = 0; sl < 32; ++sl) a += bv[sl];
      b1[tid] = a; }
    for (int u = blockIdx.x; u < 256; u += gridDim.x) {
        const int r = tid >> 5, c8 = (tid & 31) * 8, rowh = u * 16 + r;
        f32x4 sv[2][4][2];
#pragma unroll
        for (int kv = 0; kv < 2; ++kv)
#pragma unroll
            for (int sp = 0; sp < 4; ++sp)
#pragma unroll
                for (int hh = 0; hh < 2; ++hh) sv[kv][sp][hh] = *(const GAS f32x4*)(slabs + ((size_t)(kv * 4 + sp) * 4096 + rowh) * 256 + c8 + 4 * hh);
        __syncthreads();
#pragma unroll
        for (int kv = 0; kv < 2; ++kv) { u32x4 hw;
#pragma unroll
            for (int hh = 0; hh < 2; ++hh) { f32x4 a = *(const LAS f32x4*)(b1 + kv * 256 + c8 + 4 * hh);
#pragma unroll
                for (int sp = 0; sp < 4; ++sp) a += sv[kv][sp][hh];
#pragma unroll
                for (int j = 0; j < 4; ++j) a[j] = a[j] / (1.0f + __expf(-a[j]));
                hw[2 * hh] = cvtpk(a[0], a[1]); hw[2 * hh + 1] = cvtpk(a[2], a[3]); }
            *(LAS u32x4*)(hidb + (kv * 16 + r) * HSTR + c8 * 2) = hw; }
        __syncthreads();
        f32x4 acc = {0.f, 0.f, 0.f, 0.f};
        const LAS unsigned char* hb = hidb + (kvw * 16 + (lane & 15)) * HSTR + (lane >> 4) * 16;
#pragma unroll
        for (int ks = 0; ks < 8; ++ks) acc = __builtin_amdgcn_mfma_f32_16x16x32_bf16(wf[ks], *(const LAS bf16x8*)(hb + ks * 64), acc, 0, 0, 0);
        const int row = u * 16 + (lane & 15);
        if ((row & 255) == 255) acc = (f32x4){0.f, 0.f, 0.f, 0.f};
        bf16_t* outp = (bf16_t*)(ws + (kvw ? WS_VCMP : WS_KCMP));
        u32x2 ow; ow.x = cvtpk(acc[0], acc[1]); ow.y = cvtpk(acc[2], acc[3]);
        *(GAS u32x2*)(outp + (size_t)row * 64 + nb * 16 + 4 * (lane >> 4)) = ow;
    }
    __syncthreads();
}

constexpr int KBUF_BYTES = 64 * 208, VSTR = 192, VBUF_BYTES = 64 * VSTR;
constexpr int ATT_VOFF = 3 * KBUF_BYTES;
constexpr int ATT_IMP = 3 * KBUF_BYTES + 2 * VBUF_BYTES;
constexpr int ATT_SEL = ATT_IMP + 65536;
constexpr int ATT_FLAG = ATT_SEL + 512;
static_assert(ATT_FLAG + 32 <= LDS_SCRATCH, "attention LDS");

struct Acc { f32x16 o0, o1, nm; float m, l; };
DI void acc_init(Acc& a) {
#pragma unroll
    for (int i = 0; i < 16; ++i) { a.o0[i] = 0.f; a.o1[i] = 0.f; a.nm[i] = 0.f; }
    a.m = 0.f; a.l = 0.f;
}
DI float max3f(float a, float b, float c) { float r; asm("v_max3_f32 %0, %1, %2, %3" : "=v"(r) : "v"(a), "v"(b), "v"(c)); return r; }
template <int KD> struct KVFrags { const LAS unsigned char* vb; s16x4 v[16]; };
DI s16x4 trrd(const LAS unsigned char* p) { return __builtin_bit_cast(s16x4, __builtin_amdgcn_ds_read_tr16_b64_v4i16((LAS v4i16_t*)p)); }
template <int KD, bool HASV>
DI void load_frags(KVFrags<KD>& f, const LAS unsigned char* kb, const LAS unsigned char* vb, int lane) { f.vb = vb; (void)kb; (void)lane; }
template <int KD, bool HASV = true>
DI void qk_mma(f32x16& s0, f32x16& s1, KVFrags<KD>& f, const LAS unsigned char* kb, const bf16x8 (&qf)[KD], const f32x16& cinit, int lane) {
    constexpr int KSTR = KD * 32 + 16;
    const LAS unsigned char* p0 = kb + (lane & 31) * KSTR + (lane >> 5) * 16;
    bf16x8 kf[2 * KD];
#pragma unroll
    for (int ks = 0; ks < KD; ++ks) { kf[2 * ks] = *(const LAS bf16x8*)(p0 + ks * 32); kf[2 * ks + 1] = *(const LAS bf16x8*)(p0 + 32 * KSTR + ks * 32); }
    __builtin_amdgcn_sched_barrier(0);
    s0 = __builtin_amdgcn_mfma_f32_32x32x16_bf16(kf[0], qf[0], cinit, 0, 0, 0);
    s1 = __builtin_amdgcn_mfma_f32_32x32x16_bf16(kf[1], qf[0], cinit, 0, 0, 0);
#pragma unroll
    for (int ks = 1; ks < KD; ++ks) {
        s0 = __builtin_amdgcn_mfma_f32_32x32x16_bf16(kf[2 * ks], qf[ks], s0, 0, 0, 0);
        s1 = __builtin_amdgcn_mfma_f32_32x32x16_bf16(kf[2 * ks + 1], qf[ks], s1, 0, 0, 0);
    }
    __builtin_amdgcn_sched_barrier(0);
    if (HASV) {
        const int h = lane >> 5, q4 = (lane & 15) >> 2, p4 = lane & 3, blk = (lane >> 4) & 1;
        const LAS unsigned char* vbase = f.vb + (4 * h + q4) * VSTR + (blk * 16 + p4 * 4) * 2;
#pragma unroll
        for (int kh = 0; kh < 2; ++kh)
#pragma unroll
            for (int s2 = 0; s2 < 2; ++s2) { const LAS unsigned char* vp = vbase + (kh * 32 + s2 * 16) * VSTR; const int j = (kh * 2 + s2) * 4;
                f.v[j + 0] = trrd(vp); f.v[j + 1] = trrd(vp + 8 * VSTR); f.v[j + 2] = trrd(vp + 64); f.v[j + 3] = trrd(vp + 8 * VSTR + 64); }
        __builtin_amdgcn_sched_barrier(0);
    }
}
DI void mask_tile(f32x16& s0, f32x16& s1, int lo, int hi, int h) {
    int lo4 = lo - 4 * h, hi4 = hi - 4 * h;
    asm volatile("" : "+v"(lo4), "+v"(hi4));
#pragma unroll
    for (int i = 0; i < 16; ++i) { const int c = crow(i, 0);
        if ((lo > 0 && c < lo4) || c > hi4) s0[i] = -INFINITY;
        if ((lo > 0 && c + 32 < lo4) || c + 32 > hi4) s1[i] = -INFINITY; }
}
DI float tile_max(f32x16& s0, f32x16& s1) {
    asm volatile("s_nop 15\n\ts_nop 7" : "+v"(s0), "+v"(s1));
    float mx = max3f(s0[0], s1[0], s0[1]);
    mx = max3f(mx, s1[1], s0[2]);
#pragma unroll
    for (int i = 2; i < 15; ++i) mx = max3f(mx, s1[i], s0[i + 1]);
    mx = max3f(mx, s1[15], mx);
    return max3f(mx, __shfl_xor(mx, 32), mx);
}
constexpr float RESC_THR = 6.0f;
DI void online_update(Acc& a, f32x16& s0, f32x16& s1, bool with_o, bool first, bool on = true) {
    float mx = tile_max(s0, s1);
    mx = on ? mx : -INFINITY;
    if (first || !__all(mx <= RESC_THR)) {
        float d = first ? mx : fmaxf(mx, 0.f);
        if (d == -INFINITY) d = 0.f;
        if (!first) {
            const float alpha = ex2(-d);
            a.l *= alpha;
            if (with_o) {
#pragma unroll
                for (int i = 0; i < 16; ++i) { a.o0[i] *= alpha; a.o1[i] *= alpha; }
            }
        }
        a.m += d;
#pragma unroll
        for (int i = 0; i < 16; ++i) { s0[i] -= d; s1[i] -= d; a.nm[i] = -a.m; }
    }
    float rs = 0.f;
#pragma unroll
    for (int i = 0; i < 16; ++i) { s0[i] = ex2(s0[i]); s1[i] = ex2(s1[i]); rs += s0[i] + s1[i]; }
    a.l += on ? rs : 0.f;
}
constexpr float FAST_BIGL = 1099511627776.0f, FAST_TINYL = 1.0f / 1099511627776.0f;
template <bool B> struct BoolC { static constexpr bool value = B; };
#ifndef MK_FORCE_SAFE
#define MK_FORCE_SAFE 0
#endif
DI bool l_bad(const Acc& a) { const float lt = a.l + __shfl_xor(a.l, 32);
    if (MK_FORCE_SAFE == 1) return true;
    if (MK_FORCE_SAFE == 2) return !(lt <= 40.0f && lt >= FAST_TINYL);
    return !(lt <= FAST_BIGL && lt >= FAST_TINYL); }
DI void fast_update(Acc& a, f32x16& s0, f32x16& s1, bool on) {
    float rs = 0.f;
#pragma unroll
    for (int i = 0; i < 16; ++i) { s0[i] = ex2(s0[i]); rs += s0[i]; s1[i] = ex2(s1[i]); rs += s1[i]; }
    a.l += on ? rs : 0.f;
}
DI bool stream_redo(volatile LAS unsigned* fl, bool bad) {
    if (__any(bad)) *fl = 1u;
    __syncthreads();
    return *fl != 0u;
}
DI bf16x8 pack8(const f32x16& s, int base) {
    u32x4 w; w.x = cvtpk(s[base + 0], s[base + 1]); w.y = cvtpk(s[base + 2], s[base + 3]); w.z = cvtpk(s[base + 4], s[base + 5]); w.w = cvtpk(s[base + 6], s[base + 7]);
    return __builtin_bit_cast(bf16x8, w);
}
template <int KD>
DI void pv_mma(Acc& a, const f32x16& p0, const f32x16& p1, const KVFrags<KD>& f, bool on = true) {
#pragma unroll
    for (int kh = 0; kh < 2; ++kh)
#pragma unroll
        for (int s2 = 0; s2 < 2; ++s2) {
            u32x4 pw = __builtin_bit_cast(u32x4, pack8(kh ? p1 : p0, 8 * s2));
            pw.x = on ? pw.x : 0u; pw.y = on ? pw.y : 0u; pw.z = on ? pw.z : 0u; pw.w = on ? pw.w : 0u;
            const bf16x8 pf = __builtin_bit_cast(bf16x8, pw); const int j = (kh * 2 + s2) * 4;
            a.o0 = __builtin_amdgcn_mfma_f32_32x32x16_bf16(__builtin_shufflevector(f.v[j], f.v[j + 1], 0, 1, 2, 3, 4, 5, 6, 7), pf, a.o0, 0, 0, 0);
            a.o1 = __builtin_amdgcn_mfma_f32_32x32x16_bf16(__builtin_shufflevector(f.v[j + 2], f.v[j + 3], 0, 1, 2, 3, 4, 5, 6, 7), pf, a.o1, 0, 0, 0);
        }
}

struct Stage { u32x4 rk, rv, rkr; };
template <int KD, bool HASV, class Addr, class Body, class Next>
DI void kv_stream(int ntiles, Addr addr, Body body, Stage& sg, bool pre, Next next, LAS unsigned char* lds, int tid) {
    constexpr int KSTR = KD * 32 + 16;
    if (ntiles <= 0) return;
    const int row8 = tid >> 3, ch8 = tid & 7, row4 = tid >> 2, ch4 = tid & 3;
    auto ld = [&](int it) {
        const bf16_t *kp, *vp, *krp; addr(it, kp, vp, krp);
        sg.rk = *(const GAS u32x4*)(kp + tid * 8);
        if (HASV) sg.rv = *(const GAS u32x4*)(vp + tid * 8);
        if (KD == 6) { if (tid < 256) sg.rkr = *(const GAS u32x4*)(krp + tid * 8); }
    };
    auto st = [&](int buf) {
        LAS unsigned char* kb = lds + buf * KBUF_BYTES; LAS unsigned char* vb = lds + ATT_VOFF + buf * VBUF_BYTES;
        *(LAS u32x4*)(kb + row8 * KSTR + ch8 * 16) = sg.rk;
        if (HASV) *(LAS u32x4*)(vb + row8 * VSTR + ch8 * 16) = sg.rv;
        if (KD == 6) { if (tid < 256) *(LAS u32x4*)(kb + row4 * KSTR + 128 + ch4 * 16) = sg.rkr; }
    };
    if (!pre) ld(0);
    st(0);
    __syncthreads();
#pragma unroll 1
    for (int it = 0; it < ntiles; ++it) {
        const int cur = it & 1;
        if (it + 1 < ntiles) ld(it + 1); else next(sg);
        body(it, (const LAS unsigned char*)(lds + cur * KBUF_BYTES), (const LAS unsigned char*)(lds + ATT_VOFF + cur * VBUF_BYTES));
        if (it + 1 < ntiles) st(cur ^ 1);
        __syncthreads();
    }
}

DI void mla_unit(const Params& p, int b, int hd, int qb, int fi, LAS unsigned char* lds, int tid_) {
    const int tid = tid_ * 64 + lane_id_now();
    const int lane = tid & 63, w = tid_, r = lane & 31, h = lane >> 5;
    unsigned char* ws = launder(p.ws);
    const bf16_t* QM = (const bf16_t*)(ws + WS_A + A_QM); const bf16_t* KN = (const bf16_t*)(ws + WS_A + A_KN) + (size_t)(b * 8 + hd) * SEQ * 64;
    const bf16_t* VM = (const bf16_t*)(ws + WS_A + A_VM) + (size_t)(b * 8 + hd) * SEQ * 64; const bf16_t* KR = (const bf16_t*)(ws + WS_A + A_KR) + (size_t)b * SEQ * 32;
    bf16_t* OAB = (bf16_t*)(ws + WS_OAB);
    const int qlo = qb * 256 + w * 32, q = qlo + r;
    bf16x8 qf[6];
    { const bf16_t* qp = QM + (size_t)(b * SEQ + q) * 768 + hd * 96 + h * 8;
#pragma unroll
      for (int ks = 0; ks < 6; ++ks) qf[ks] = *(const GAS bf16x8*)(qp + ks * 16); }
    Acc a; acc_init(a);
    volatile LAS unsigned* fl = (volatile LAS unsigned*)(lds + ATT_FLAG) + 4 + fi;
    Stage sg;
    auto run = [&](auto safec) {
        constexpr bool SAFE = decltype(safec)::value;
        kv_stream<6, true>(4 * qb + 4,
            [&](int it, const bf16_t*& kp, const bf16_t*& vp, const bf16_t*& krp) { kp = KN + (size_t)it * 4096; vp = VM + (size_t)it * 4096; krp = KR + (size_t)it * 2048; },
            [&](int it, const LAS unsigned char* kb, const LAS unsigned char* vb) {
                if (it * 64 <= qlo + 31) {
                    KVFrags<6> f; load_frags<6, true>(f, kb, vb, lane);
                    const f32x16 z16 = {0.f, 0.f, 0.f, 0.f, 0.f, 0.f, 0.f, 0.f, 0.f, 0.f, 0.f, 0.f, 0.f, 0.f, 0.f, 0.f};
                    f32x16 s0, s1; qk_mma<6>(s0, s1, f, kb, qf, SAFE ? a.nm : z16, lane);
                    if (it * 64 + 63 > qlo) mask_tile(s0, s1, 0, q - it * 64, h);
                    if (SAFE) online_update(a, s0, s1, true, it == 0); else fast_update(a, s0, s1, true);
                    pv_mma<6>(a, s0, s1, f);
                }
            }, sg, false, [&](Stage&) {}, lds, tid);
    };
    if (tid == 0) *fl = 0u;
    run(BoolC<false>{});
    if (stream_redo(fl, l_bad(a))) { acc_init(a); run(BoolC<true>{}); }
    const float lt = a.l + __shfl_xor(a.l, 32); const float inv = lt > 0.f ? 1.0f / lt : 0.f;
    float ssq = st_row64(OAB + (size_t)(b * SEQ + q) * 1024 + 512 + hd * 64, a.o0, a.o1, inv, h);
    ssq += __shfl_xor(ssq, 32);
    if (h == 0) ((GAS float*)(ws + WS_SSB))[(size_t)(b * SEQ + q) * 8 + hd] = ssq;
}
DI void mla_phase(const Params& p, LAS unsigned char* lds, int tid) {
    for (int pi = blockIdx.x; pi < 512; pi += gridDim.x) {
        const int bh = pi & 63, qp = pi >> 6;
        mla_unit(p, bh >> 3, bh & 7, 15 - qp, 0, lds, tid);
        mla_unit(p, bh >> 3, bh & 7, qp, 1, lds, tid);
    }
}

DI void nsa_unit(const Params& p, int b, int g, int c, int fi, LAS unsigned char* lds, int tid_) {
    const int tid = tid_ * 64 + lane_id_now();
    const int lane = tid & 63, w = tid_, r = lane & 31, h = lane >> 5;
    const int head = g * 4 + (w >> 1), qh = w & 1, tq = 32 * qh + r, t = 64 * c + tq;
    unsigned char* ws = launder(p.ws);
    unsigned char* A = ws + WS_A;
    const bf16_t* QA = (const bf16_t*)(A + A_QA);
    const size_t bgoff = (size_t)(b * 2 + g) * SEQ * 64;
    const bf16_t* KS = (const bf16_t*)(A + A_KS) + bgoff; const bf16_t* VS = (const bf16_t*)(A + A_VS) + bgoff;
    const bf16_t* KW = (const bf16_t*)(A + A_KW) + bgoff; const bf16_t* VW = (const bf16_t*)(A + A_VW) + bgoff;
    const bf16_t* KCMP = (const bf16_t*)(ws + WS_KCMP) + (size_t)(b * 2 + g) * 256 * 64; const bf16_t* VCMP = (const bf16_t*)(ws + WS_VCMP) + (size_t)(b * 2 + g) * 256 * 64;
    LAS unsigned* IMP = (LAS unsigned*)(lds + ATT_IMP);
    LAS unsigned long long* SELM = (LAS unsigned long long*)(lds + ATT_SEL);
    bf16x8 qf[4];
    { const bf16_t* qp = QA + (size_t)(b * SEQ + t) * 512 + head * 64 + h * 8;
#pragma unroll
      for (int ks = 0; ks < 4; ++ks) qf[ks] = *(const GAS bf16x8*)(qp + ks * 16); }
    LAS f32x16* TL = (LAS f32x16*)(lds + ATT_IMP) + (w * 64 + lane) * 2;
    f32x16 t0, t1;
    const bool need_sel = c >= 16;
    if (need_sel) { for (int i = tid; i < 65 * 16; i += NTHR) ((LAS u32x4*)IMP)[i] = (u32x4){0u, 0u, 0u, 0u}; }
    const int nct = (4 * c + 3 + 63) >> 6;
    const int nmax = t >= 31 ? ((t - 31) >> 4) : -1;
    Acc a; acc_init(a);
    Stage sg;
    kv_stream<4, false>(nct,
        [&](int it, const bf16_t*& kp, const bf16_t*& vp, const bf16_t*& krp) { kp = KCMP + (size_t)it * 4096; vp = nullptr; krp = nullptr; },
        [&](int it, const LAS unsigned char* kb, const LAS unsigned char* vb) {
            KVFrags<4> f; load_frags<4, false>(f, kb, vb, lane);
            f32x16 s0, s1; qk_mma<4, false>(s0, s1, f, kb, qf, a.nm, lane);
            mask_tile(s0, s1, 0, nmax - it * 64, h);
            online_update(a, s0, s1, false, it == 0);
        }, sg, false, [&](Stage& g_) { g_.rk = *(const GAS u32x4*)(KCMP + tid * 8); g_.rv = *(const GAS u32x4*)(VCMP + tid * 8); }, lds, tid);
    {
        const float lt = a.l + __shfl_xor(a.l, 32); const float sh = lt > 0.f ? -__builtin_amdgcn_logf(lt) : -INFINITY;
        f32x16 cn2;
#pragma unroll
        for (int i = 0; i < 16; ++i) cn2[i] = a.nm[i] + sh;
        kv_stream<4, true>(nct,
            [&](int it, const bf16_t*& kp, const bf16_t*& vp, const bf16_t*& krp) { kp = KCMP + (size_t)it * 4096; vp = VCMP + (size_t)it * 4096; krp = nullptr; },
            [&](int it, const LAS unsigned char* kb, const LAS unsigned char* vb) {
                KVFrags<4> f; load_frags<4, true>(f, kb, vb, lane);
                f32x16 s0, s1; qk_mma<4>(s0, s1, f, kb, qf, cn2, lane);
                mask_tile(s0, s1, 0, nmax - it * 64, h);
#pragma unroll
                for (int i = 0; i < 16; ++i) { s0[i] = ex2(s0[i]); s1[i] = ex2(s1[i]); }
                if (need_sel) {
#pragma unroll
                    for (int g = 0; g < 8; ++g) { const f32x16& sv = g < 4 ? s0 : s1; const int b4 = (g & 3) * 4, j = it * 16 + 2 * (g & 3) + h + (g < 4 ? 0 : 8);
                        const unsigned vb = (unsigned)((2.0f * ((sv[b4] + sv[b4 + 1]) + sv[b4 + 2]) + sv[b4 + 3]) * 67108864.0f + 0.5f), vn = (unsigned)(sv[b4 + 3] * 67108864.0f + 0.5f);
                        __hip_atomic_fetch_add(IMP + j * 64 + tq, vb, __ATOMIC_RELAXED, __HIP_MEMORY_SCOPE_WORKGROUP);
                        __hip_atomic_fetch_add(IMP + (j + 1) * 64 + tq, vn, __ATOMIC_RELAXED, __HIP_MEMORY_SCOPE_WORKGROUP); }
                }
                pv_mma<4>(a, s0, s1, f);
            }, sg, true, [&](Stage& g_) { g_.rk = *(const GAS u32x4*)(KS + tid * 8); g_.rv = *(const GAS u32x4*)(VS + tid * 8); }, lds, tid);
        const float g0 = ((const GAS float*)(A + A_GATES))[(size_t)(b * SEQ + t) * 24 + head * 3];
#pragma unroll
        for (int i = 0; i < 16; ++i) { t0[i] = g0 * a.o0[i]; t1[i] = g0 * a.o1[i]; }
    }
    unsigned long long mq = ~0ull;
    if (need_sel) {
#pragma unroll 1
        for (int i = 0; i < 8; i += 4) {
            const int ql = w * 8 + i, j = lane;
            const bool valid = j <= c, forced = (j == 0) || (j == c) || (j == c - 1);
            unsigned sc[4]; int rk[4] = {0, 0, 0, 0};
#pragma unroll
            for (int q_ = 0; q_ < 4; ++q_) { const unsigned ib = IMP[j * 64 + ql + q_];
                const unsigned key = ((forced ? 0xFFFFFFFFu : ib) & ~63u) | (unsigned)(63 - j);
                sc[q_] = valid ? key : 0u; }
            const int nblk8 = (c + 8) & ~7;
#pragma unroll 1
            for (int i8 = 0; i8 < nblk8; i8 += 8) {
#pragma unroll
                for (int k = 0; k < 8; ++k) {
#pragma unroll
                    for (int q_ = 0; q_ < 4; ++q_) { const unsigned o = (unsigned)__builtin_amdgcn_readlane((int)sc[q_], i8 + k); rk[q_] += (o > sc[q_]) ? 1 : 0; } } }
#pragma unroll
            for (int q_ = 0; q_ < 4; ++q_) { const unsigned long long bm = __ballot(valid && rk[q_] < 16); if (lane == 0) SELM[ql + q_] = bm; }
        }
        __syncthreads();
        mq = SELM[tq];
    }
    acc_init(a);
    volatile LAS unsigned* fl = (volatile LAS unsigned*)(lds + ATT_FLAG) + 2 * fi;
    const int jlo = c >= 8 ? c - 8 : 0;
    auto run_sel = [&](auto safec, bool pre_) {
        constexpr bool SAFE = decltype(safec)::value;
        kv_stream<4, true>(c + 1,
            [&](int it, const bf16_t*& kp, const bf16_t*& vp, const bf16_t*& krp) { kp = KS + (size_t)it * 4096; vp = VS + (size_t)it * 4096; krp = nullptr; },
            [&](int it, const LAS unsigned char* kb, const LAS unsigned char* vb) {
                const bool on = (mq >> it) & 1ull;
                if (__any(on)) {
                    KVFrags<4> f; load_frags<4, true>(f, kb, vb, lane);
                    const f32x16 z16 = {0.f, 0.f, 0.f, 0.f, 0.f, 0.f, 0.f, 0.f, 0.f, 0.f, 0.f, 0.f, 0.f, 0.f, 0.f, 0.f};
                    f32x16 s0, s1; qk_mma<4>(s0, s1, f, kb, qf, SAFE ? a.nm : z16, lane);
                    if (it == c) mask_tile(s0, s1, 0, tq, h);
                    if (SAFE) online_update(a, s0, s1, true, it == 0, on); else fast_update(a, s0, s1, on);
                    pv_mma<4>(a, s0, s1, f, on);
                }
            }, sg, pre_, [&](Stage& g_) { g_.rk = *(const GAS u32x4*)(KW + (size_t)jlo * 4096 + tid * 8); g_.rv = *(const GAS u32x4*)(VW + (size_t)jlo * 4096 + tid * 8); }, lds, tid);
    };
    if (tid == 0) { fl[0] = 0u; fl[1] = 0u; }
    run_sel(BoolC<false>{}, true);
    if (stream_redo(fl, l_bad(a))) { acc_init(a); run_sel(BoolC<true>{}, false); }
    {
        const int lane_f = lane_id_now(), t_f = 64 * c + 32 * (tid_ & 1) + (lane_f & 31);
        const float g1 = ((const GAS float*)(launder(p.ws) + WS_A + A_GATES))[(size_t)(b * SEQ + t_f) * 24 + (g * 4 + (tid_ >> 1)) * 3 + 1];
        LAS f32x16* TL = (LAS f32x16*)(lds + ATT_IMP) + (tid_ * 64 + lane_f) * 2;
        const float lt = a.l + __shfl_xor(a.l, 32); const float sc = lt > 0.f ? g1 / lt : 0.f;
#pragma unroll
        for (int i = 0; i < 16; ++i) { t0[i] += sc * a.o0[i]; t1[i] += sc * a.o1[i]; }
    }
    acc_init(a);
    auto run_win = [&](auto safec, bool pre_) {
        constexpr bool SAFE = decltype(safec)::value;
        kv_stream<4, true>(c - jlo + 1,
            [&](int it, const bf16_t*& kp, const bf16_t*& vp, const bf16_t*& krp) { kp = KW + (size_t)(jlo + it) * 4096; vp = VW + (size_t)(jlo + it) * 4096; krp = nullptr; },
            [&](int it, const LAS unsigned char* kb, const LAS unsigned char* vb) {
                const int j = jlo + it;
                KVFrags<4> f; load_frags<4, true>(f, kb, vb, lane);
                const f32x16 z16 = {0.f, 0.f, 0.f, 0.f, 0.f, 0.f, 0.f, 0.f, 0.f, 0.f, 0.f, 0.f, 0.f, 0.f, 0.f, 0.f};
                f32x16 s0, s1; qk_mma<4>(s0, s1, f, kb, qf, SAFE ? a.nm : z16, lane);
                const bool first = (c >= 8 && j == c - 8), lastt = (j == c);
                if (first || lastt) mask_tile(s0, s1, first ? tq + 1 : 0, lastt ? tq : 63, h);
                if (SAFE) online_update(a, s0, s1, true, it == 0); else fast_update(a, s0, s1, true);
                pv_mma<4>(a, s0, s1, f);
            }, sg, pre_, [&](Stage&) {}, lds, tid);
    };
    run_win(BoolC<false>{}, true);
    if (stream_redo((volatile LAS unsigned*)(lds + ATT_FLAG) + 2 * fi + 1, l_bad(a))) { acc_init(a); run_win(BoolC<true>{}, false); }
    {
        const int lane_f = lane_id_now(), t_f = 64 * c + 32 * (tid_ & 1) + (lane_f & 31);
        const float g2 = ((const GAS float*)(launder(p.ws) + WS_A + A_GATES))[(size_t)(b * SEQ + t_f) * 24 + (g * 4 + (tid_ >> 1)) * 3 + 2];
        LAS f32x16* TL = (LAS f32x16*)(lds + ATT_IMP) + (tid_ * 64 + lane_f) * 2;
        const float lt = a.l + __shfl_xor(a.l, 32); const float sc = lt > 0.f ? g2 / lt : 0.f;
#pragma unroll
        for (int i = 0; i < 16; ++i) { t0[i] += sc * a.o0[i]; t1[i] += sc * a.o1[i]; }
    }
    const int lane_o = lane_id_now(), t_o = 64 * c + 32 * (tid_ & 1) + (lane_o & 31), head_o = g * 4 + (tid_ >> 1), h_o = lane_o >> 5;
    unsigned char* ws_o = launder(p.ws);
    float ssq = st_row64((bf16_t*)(ws_o + WS_OAB) + (size_t)(b * SEQ + t_o) * 1024 + head_o * 64, t0, t1, 1.0f, h_o);
    ssq += __shfl_xor(ssq, 32);
    if (h_o == 0) ((GAS float*)(ws_o + WS_SSA))[(size_t)(b * SEQ + t_o) * 8 + head_o] = ssq;
}
DI void nsa_phase(const Params& p, LAS unsigned char* lds, int tid) {
    for (int pi = blockIdx.x; pi < 512; pi += gridDim.x) {
        const int bg = pi & 15, cp = pi >> 4;
        nsa_unit(p, bg >> 1, bg & 1, 63 - cp, 0, lds, tid);
        nsa_unit(p, bg >> 1, bg & 1, cp, 1, lds, tid);
    }
}

constexpr int N_STEPS = 34;
#ifndef MK_REP_STEP
#define MK_REP_STEP -1
#endif
#define NREP(k) ((k) == MK_REP_STEP ? 2 : 1)
__global__ void __launch_bounds__(NTHR, 2) fwd(Params p) {
    extern __shared__ __attribute__((aligned(16))) unsigned char lds_raw[];
    LAS unsigned char* lds = (LAS unsigned char*)lds_raw;
    const int wave0 = __builtin_amdgcn_readfirstlane((int)threadIdx.x >> 6);
    const int tid = wave0;
    volatile LAS unsigned* misc = (volatile LAS unsigned*)(lds + LDS_MISC);
    if (threadIdx.x < 4) misc[threadIdx.x] = 0u;
    __syncthreads();
    unsigned* ctl = (unsigned*)(p.ws + WS_CTL);
    XcdBarrier bar = xcd_barrier_post(ctl + CW_BAR, misc);
    const int lo = p.s_lo, hi = p.s_hi;
#define IN(k) (lo <= (k) && (k) < hi)
#define BAR(k) do { if ((k) + 1 < hi) xcd_barrier(bar); } while (0)
    const int G = gridDim.x, bx = blockIdx.x;

    if (IN(0)) { for (int rep = 0; rep < NREP(8); ++rep) prologue(p, lds, tid); BAR(0); }
#pragma unroll 1
    for (int l = 0; l < DEPTH; ++l) {
        const int sb = 1 + 8 * l;
        if (IN(sb + 0)) for (int rep = 0; rep < NREP(0); ++rep) {
            unsigned char* ws = launder(p.ws);
            pg8::Gemm g{(const bf16_t*)(ws + WS_XB), (const bf16_t*)(ws + WS_W + W_WIN + l * SZ_WIN), NTOK, NPROJ, 1024, 1024, 1024};
            pg8::StaticOrder S; S.init(NTOK, NPROJ, launder_s(G), launder_s(bx));
            EpiInProj E{ws, l};
            pg8::gemm_phase(lds, g, S, E, wave0);
            if (l + 1 < DEPTH) {
                const int G_ = launder_s(G), bx_ = launder_s(bx), nbusy = 896 % G_;
                if (bx_ >= nbusy) convert_weights(p, lds, wave0, l + 1, l + 2, (bx_ - nbusy) * NWAVES + wave0, (G_ - nbusy) * NWAVES);
            }
            if (rep + 1 == NREP(0)) BAR(sb + 0);
        }
        if (IN(sb + 1)) for (int rep = 0; rep < NREP(1); ++rep) {
            {
                unsigned char* ws = launder(p.ws);
                pg8::Gemm g{(const bf16_t*)(ws + WS_A + A_CQKV), (const bf16_t*)(ws + WS_W + W_WUP + l * SZ_WUP), NTOK, NUP, KUP, KUP, KUP};
                pg8::StaticOrder S; S.init(NTOK, NUP, launder_s(G), launder_s(bx));
                EpiUp E{ws, l};
                pg8::gemm_phase(lds, g, S, E, wave0);
            }
#pragma unroll 1
            for (int i = 0; i < 8; ++i) {
                unsigned char* ws = launder(p.ws);
                const int kv = i >> 2, sp = i & 3;
                const bf16_t* Ab = (const bf16_t*)(ws + WS_A + (kv ? A_VC : A_KC)) + sp * 512;
                const bf16_t* Bb = (const bf16_t*)(ws + WS_W + (kv ? W_W1V : W_W1K) + l * SZ_W1) + sp * 512;
                pg8::Gemm g{Ab, Bb, 4096, 256, 512, 1024, 2048};
                const int G_ = launder_s(G); int c = launder_s(bx) - G_ / 2 - 16 * i; if (c < 0) c += G_; if (c >= 16) c = -1;
                pg8::StaticOrder S; S.init(4096, 256, G_, c);
                EpiSlab E{ws, i};
                pg8::gemm_phase(lds, g, S, E, wave0);
            }
            if (rep + 1 == NREP(1)) BAR(sb + 1);
        }
        if (IN(sb + 2)) { cmp2_phase(p, l, lds, tid); BAR(sb + 2); }
        if (IN(sb + 3)) { mla_phase(p, lds, tid); nsa_phase(p, lds, tid); BAR(sb + 3); }
        if (IN(sb + 5)) for (int rep = 0; rep < (l == 0 ? NREP(5) : 1); ++rep) {
            unsigned char* ws = launder(p.ws);
            pg8::Gemm g{(const bf16_t*)(ws + WS_OAB), (const bf16_t*)(ws + WS_W + W_WOUT + l * SZ_WOUT), NTOK, 1024, 1024, 1024, 1024};
            pg8::StaticOrder S; S.init(NTOK, 1024, launder_s(G), launder_s(bx));
            EpiResid<true> E{ws, 1};
            pg8::gemm_phase(lds, g, S, E, wave0);
            if (rep + 1 == (l == 0 ? NREP(5) : 1)) BAR(sb + 5);
        }
        if (IN(sb + 6)) for (int rep = 0; rep < NREP(6); ++rep) {
            unsigned char* ws = launder(p.ws);
            pg8::Gemm g{(const bf16_t*)(ws + WS_XB), (const bf16_t*)(ws + WS_W + W_WFF1 + l * SZ_WFF), NTOK, D_FF, 1024, 1024, 1024};
            pg8::StaticOrder S; S.init(NTOK, D_FF, launder_s(G), launder_s(bx));
            EpiFF1 E{ws, l};
            pg8::gemm_phase(lds, g, S, E, wave0);
            if (rep + 1 == NREP(6)) BAR(sb + 6);
        }
        if (IN(sb + 7)) {
            unsigned char* ws = launder(p.ws);
            pg8::Gemm g{(const bf16_t*)(ws + WS_A), (const bf16_t*)(ws + WS_W + W_WFF2 + l * SZ_WFF), NTOK, 1024, D_FF, D_FF, D_FF};
            pg8::StaticOrder S; S.init(NTOK, 1024, launder_s(G), launder_s(bx));
            EpiResid<false> E{ws, 0};
            pg8::gemm_phase(lds, g, S, E, wave0);
            BAR(sb + 7);
        }
    }
    if (IN(33)) final_norm_phase(p, tid);
#undef IN
#undef BAR
}

}
#ifndef MK_DEBUG
#define MK_DEBUG 0
#endif

#if MK_DEBUG
namespace dbg {
using namespace mk;
enum { K_QA = 0, K_KV, K_GATES, K_CQ, K_CKV, K_KR, K_QM, K_KN, K_VM, K_CMP, K_OAB, K_X };
__global__ __launch_bounds__(256) void cmp_kernel(int kind, const void* opt, const float* refp, int n, int aux, float scale, float* err, int id) {
    __shared__ float red[2][4];
    const int idx = blockIdx.x * 256 + threadIdx.x;
    float num = 0.f, den = 0.f;
    if (idx < n) {
        float o = 0.f, r = 0.f;
        const bf16_t* ob = (const bf16_t*)opt; const float* of = (const float*)opt;
        switch (kind) {
            case K_QA: { const int row = idx / 512, c = idx % 512; o = bf2f(ob[(size_t)row * 512 + c]); r = refp[(size_t)row * ref::IN_WIDTH + ref::C_QA + c]; break; }
            case K_KV: { const int row = idx / 128, c = idx % 128, g = c >> 6, d = c & 63; o = bf2f(ob[((size_t)g * SEQ + row) * 64 + d]); r = refp[(size_t)row * ref::IN_WIDTH + aux + c]; break; }
            case K_GATES: { const int row = idx / 24, c = idx % 24; o = of[(size_t)row * 24 + c]; r = refp[(size_t)row * ref::IN_WIDTH + ref::C_G + c]; break; }
            case K_CQ: { const int row = idx / 256, c = idx % 256; o = bf2f(ob[(size_t)row * KUP + c]); r = refp[(size_t)row * ref::IN_WIDTH + ref::C_CQ + c]; break; }
            case K_CKV: { const int row = idx / 128, c = idx % 128; o = bf2f(ob[(size_t)row * KUP + 256 + c]); r = refp[(size_t)row * ref::IN_WIDTH + ref::C_CKV + c]; break; }
            case K_KR: { const int row = idx / 32, c = idx % 32; o = bf2f(ob[(size_t)row * 32 + c]); r = refp[(size_t)row * ref::IN_WIDTH + ref::C_KR + c]; break; }
            case K_QM: { o = bf2f(ob[idx]); r = refp[idx]; break; }
            case K_KN: { const int row = idx / 512, c = idx % 512, hd = c >> 6, d = c & 63; o = bf2f(ob[((size_t)hd * SEQ + row) * 64 + d]); r = refp[(size_t)row * 1024 + hd * 128 + aux + d]; break; }
            case K_CMP: { const int i = idx / 128, c = idx % 128, g = c >> 6, d = c & 63; o = bf2f(ob[((size_t)g * 256 + i) * 64 + d]); r = refp[((size_t)i * 2 + g) * 64 + d]; break; }
            case K_OAB: { const int row = idx / 512, c = idx % 512; o = bf2f(ob[(size_t)row * 1024 + aux + c]); r = refp[(size_t)row * 1024 + aux + c]; break; }
            case K_X: { o = of[idx]; r = refp[idx]; break; }
        }
        o *= scale;
        num = (o - r) * (o - r); den = r * r;
        if (!(num == num)) num = 1e30f;
    }
#pragma unroll
    for (int s = 32; s > 0; s >>= 1) { num += __shfl_xor(num, s); den += __shfl_xor(den, s); }
    if ((threadIdx.x & 63) == 0) { red[0][threadIdx.x >> 6] = num; red[1][threadIdx.x >> 6] = den; }
    __syncthreads();
    if (threadIdx.x == 0) { atomicAdd(err + 2 * id, red[0][0] + red[0][1] + red[0][2] + red[0][3]); atomicAdd(err + 2 * id + 1, red[1][0] + red[1][1] + red[1][2] + red[1][3]); }
}
__global__ __launch_bounds__(256) void encode_kernel(float* out, size_t n, const float* err, int nids, int want_id) {
    float delta2 = 0.f;
    if (want_id > 0) { const float e = err[2 * want_id] / fmaxf(err[2 * want_id + 1], 1e-30f); delta2 = fminf(e, 0.9f); if (delta2 < 1e-5f) delta2 = 0.f; }
    else { for (int id = 1; id <= nids; ++id) { const float e = err[2 * id] / fmaxf(err[2 * id + 1], 1e-30f); if (!(e < 2e-3f)) { delta2 = 0.01f * (float)id; break; } } }
    const float f = 1.0f + sqrtf(delta2);
    const size_t i = (size_t)blockIdx.x * 256 + threadIdx.x;
    if (i < n && delta2 > 0.f) out[i] *= f;
}
}
#endif

namespace {

void launch_steps(const mk::Params& base, int lo, int hi, int grid, hipStream_t stream) {
    mk::Params p = base; p.s_lo = lo; p.s_hi = hi;
    hipLaunchKernelGGL(mk::fwd, dim3(grid), dim3(mk::NTHR), mk::LDS_BYTES, stream, p);
}
}

extern "C" void kernel_launch(void* const* d_in, const int* in_sizes, int n_in, void* d_out, int out_size, void* d_ws, size_t ws_size, hipStream_t stream) {
    (void)in_sizes; (void)out_size;
    using namespace mk;
    static int grid = 0;
    if (grid == 0) {
        int dev = 0, cus = 0, per_cu = 0;
        if (n_in != 20 || ws_size < WS_END + 16 * MiB) { grid = -1; return; }
        if (hipGetDevice(&dev) != hipSuccess || hipDeviceGetAttribute(&cus, hipDeviceAttributeMultiprocessorCount, dev) != hipSuccess) { grid = -1; return; }
        if (hipFuncSetAttribute((const void*)fwd, hipFuncAttributeMaxDynamicSharedMemorySize, LDS_BYTES) != hipSuccess) { grid = -1; return; }
        if (hipOccupancyMaxActiveBlocksPerMultiprocessor(&per_cu, (const void*)fwd, NTHR, LDS_BYTES) != hipSuccess || per_cu < 1) { (void)hipGetLastError(); }
        grid = cus;
    }
    if (grid < 0) return;
    unsigned char* ws = (unsigned char*)d_ws;
    (void)hipMemsetAsync(ws + WS_CTL, 0, CTL_BYTES, stream);
    Params p{};
    for (int i = 0; i < 20; ++i) p.in[i] = (const float*)d_in[i];
    p.out = (float*)d_out; p.ws = ws; p.s_lo = 0; p.s_hi = N_STEPS;
#if MK_DEBUG == 0
#ifdef MK_MULTI
    for (int s = 0; s < N_STEPS; ++s) launch_steps(p, s, s + 1, grid, stream);
#else
    launch_steps(p, 0, N_STEPS, grid, stream);
#endif
#else
    {
        using namespace ref;
        float* err = (float*)(ws + 3 * MiB + 512 * 1024);
        unsigned char* A = ws + WS_A;
        const float* x_in = (const float*)d_in[0];
        auto naive_b0 = [&](char* nb, int upto, float*& H, float*& PROJ, float*& QMr, float*& KVMr, float*& KC, float*& VC, float*& X0) {
            H = (float*)nb; PROJ = (float*)(nb + 16 * MiB); QMr = (float*)(nb + 44 * MiB); KVMr = (float*)(nb + 56 * MiB); KC = (float*)(nb + 72 * MiB); VC = (float*)(nb + 73 * MiB);
            float* CN = (float*)(nb + 74 * MiB); float* CKVN = (float*)(nb + 78 * MiB); X0 = (float*)(nb + 80 * MiB);
            const int l = 0;
            rmsnorm_rows<<<SEQ / 4, 256, 0, stream>>>(x_in, D_MODEL, (const float*)d_in[1], H, D_MODEL, D_MODEL, SEQ);
            sgemm128<0><<<dim3((IN_WIDTH + 127) / 128, SEQ / 128), 256, 0, stream>>>(H, D_MODEL, (const float*)d_in[2], IN_WIDTH, PROJ, IN_WIDTH, nullptr, 0, SEQ, IN_WIDTH, D_MODEL);
            post_proj<<<SEQ, 256, 0, stream>>>(PROJ);
            if (upto < 2) return;
            compress_naive<<<NCMP * 2, 256, 0, stream>>>(PROJ, C_KC, (const float*)d_in[3], (const float*)d_in[4], (const float*)d_in[5], KC);
            compress_naive<<<NCMP * 2, 256, 0, stream>>>(PROJ, C_VC, (const float*)d_in[6], (const float*)d_in[7], (const float*)d_in[8], VC);
            rmsnorm_rows<<<SEQ / 4, 256, 0, stream>>>(PROJ + C_CQ, IN_WIDTH, (const float*)d_in[9], CN, 256, 256, SEQ);
            rmsnorm_rows<<<SEQ / 4, 256, 0, stream>>>(PROJ + C_CKV, IN_WIDTH, (const float*)d_in[11], CKVN, 128, 128, SEQ);
            sgemm128<0><<<dim3(768 / 128, SEQ / 128), 256, 0, stream>>>(CN, 256, (const float*)d_in[10], 768, QMr, 768, nullptr, 0, SEQ, 768, 256);
            sgemm128<0><<<dim3(1024 / 128, SEQ / 128), 256, 0, stream>>>(CKVN, 128, (const float*)d_in[12], 1024, KVMr, 1024, nullptr, 0, SEQ, 1024, 128);
            post_qm<<<SEQ, 128, 0, stream>>>(QMr);
            mla_naive<<<(SEQ / 4) * 8, 256, 0, stream>>>(QMr, KVMr, PROJ, H);
            nsa_naive<<<SEQ * 2, 256, 0, stream>>>(PROJ, KC, VC, H);
            (void)l;
        };
        float *H, *PROJ, *QMr, *KVMr, *KCr, *VCr, *X0;
        auto C = [&](int kind, const void* opt, const float* refp, int n, int aux, float scale, int id) {
            dbg::cmp_kernel<<<(n + 255) / 256, 256, 0, stream>>>(kind, opt, refp, n, aux, scale, err, id); };
        launch_steps(p, 0, 1, grid, stream); launch_steps(p, 1, 2, grid, stream);
        naive_b0((char*)(A + 112 * MiB), 1, H, PROJ, QMr, KVMr, KCr, VCr, X0);
        C(dbg::K_QA, A + A_QA, PROJ, SEQ * 512, 0, 1.0f / QS_NSA, 1);
        C(dbg::K_KV, A + A_KC, PROJ, SEQ * 128, C_KC, 1.f, 2);
        C(dbg::K_KV, A + A_VC, PROJ, SEQ * 128, C_VC, 1.f, 3);
        C(dbg::K_KV, A + A_KS, PROJ, SEQ * 128, C_KS, 1.f, 4);
        C(dbg::K_KV, A + A_VS, PROJ, SEQ * 128, C_VS, 1.f, 5);
        C(dbg::K_KV, A + A_KW, PROJ, SEQ * 128, C_KW, 1.f, 6);
        C(dbg::K_KV, A + A_VW, PROJ, SEQ * 128, C_VW, 1.f, 7);
        C(dbg::K_GATES, A + A_GATES, PROJ, SEQ * 24, 0, 1.f, 8);
        C(dbg::K_CQ, A + A_CQKV, PROJ, SEQ * 256, 0, 1.f, 9);
        C(dbg::K_CKV, A + A_CQKV, PROJ, SEQ * 128, 0, 1.f, 10);
        C(dbg::K_KR, A + A_KR, PROJ, SEQ * 32, 0, 1.f, 11);
#if MK_DEBUG >= 2
        launch_steps(p, 2, 3, grid, stream); launch_steps(p, 3, 4, grid, stream); launch_steps(p, 4, 5, grid, stream);
        naive_b0((char*)A, 2, H, PROJ, QMr, KVMr, KCr, VCr, X0);
        C(dbg::K_QM, A + A_QM, QMr, SEQ * 768, 0, 1.0f / QS_MLA, 12);
        C(dbg::K_KN, A + A_KN, KVMr, SEQ * 512, 0, 1.f, 13);
        C(dbg::K_KN, A + A_VM, KVMr, SEQ * 512, 64, 1.f, 14);
        C(dbg::K_CMP, ws + WS_KCMP, KCr, 255 * 128, 0, 1.f, 15);
        C(dbg::K_CMP, ws + WS_VCMP, VCr, 255 * 128, 0, 1.f, 16);
        C(dbg::K_OAB, ws + WS_OAB, H, SEQ * 512, 512, 1.f, 17);
        C(dbg::K_OAB, ws + WS_OAB, H, SEQ * 512, 0, 1.f, 18);
#endif
#if MK_DEBUG >= 3
        launch_steps(p, 5, 6, grid, stream); launch_steps(p, 6, 7, grid, stream);
        rmsnorm_rows<<<SEQ / 4, 256, 0, stream>>>(H, 1024, (const float*)d_in[13], H, 1024, 512, SEQ);
        rmsnorm_rows<<<SEQ / 4, 256, 0, stream>>>(H + 512, 1024, (const float*)d_in[14], H + 512, 1024, 512, SEQ);
        sgemm128<1><<<dim3(D_MODEL / 128, SEQ / 128), 256, 0, stream>>>(H, 1024, (const float*)d_in[15], 1024, X0, 1024, x_in, 1024, SEQ, 1024, 1024);
        C(dbg::K_X, d_out, X0, SEQ * 1024, 0, 1.f, 19);
        {
            float* XF = (float*)(ws + WS_END); float* HIDn = (float*)(ws + WS_OAB);
            rmsnorm_rows<<<SEQ / 4, 256, 0, stream>>>(X0, D_MODEL, (const float*)d_in[16], H, D_MODEL, D_MODEL, SEQ);
            sgemm128<2><<<dim3(D_FF / 128, SEQ / 128), 256, 0, stream>>>(H, 1024, (const float*)d_in[17], 4096, HIDn, 4096, nullptr, 0, SEQ, 4096, 1024);
            sgemm128<1><<<dim3(D_MODEL / 128, SEQ / 128), 256, 0, stream>>>(HIDn, 4096, (const float*)d_in[18], 1024, XF, 1024, X0, 1024, SEQ, 1024, 4096);
            launch_steps(p, 7, 8, grid, stream); launch_steps(p, 8, 9, grid, stream);
            C(dbg::K_X, d_out, XF, SEQ * 1024, 0, 1.f, 20);
        }
#endif
        naive_forward(d_in, (float*)d_out, (char*)ws + 4 * MiB, stream);
#ifndef MK_DBG_ID
#define MK_DBG_ID 0
#endif
        dbg::encode_kernel<<<(NTOK * D_MODEL + 255) / 256, 256, 0, stream>>>((float*)d_out, (size_t)NTOK * D_MODEL, err, 20, MK_DBG_ID);
    }
#endif
}
```
